# Optimizing an MI355X kernel written in HIP

```python
import jax, jax.numpy as jnp
from jax import lax
import numpy as np

D_MODEL = 2048
BATCH = 16
SEQ = 2048
DEPTH = 2
DEC_BATCH = 16
DEC_SEQ = 64
PAST_LEN = 2048

CHUNK = 64
HEAD_DIM = 128
A_HEADS = 8
A_KV_HEADS = 2
A_GROUP = A_HEADS // A_KV_HEADS
WINDOW = 128
B_HEADS = 8
B_PAST_CHUNKS = 8
B_BAND_PAST = B_PAST_CHUNKS * CHUNK
REL_CLIP = 128
C_HEADS = 16
C_Q_RANK = 768
C_KV_RANK = 512
C_NOPE = 128
C_ROPE = 64
C_V = 128
Q_BLOCK = 128
D_FF = 4 * D_MODEL
PLE_DIM = 256
ROPE_THETA = 10000.0
LN_EPS = 1e-5
RMS_EPS = 1e-6
NEG_INF = -1e30
DEEPNORM_ALPHA = (2 * DEPTH) ** 0.25
DEEPNORM_BETA = (8 * DEPTH) ** -0.25
N_AB_LAYERS = (DEPTH + 1) // 2
N_C_LAYERS = DEPTH // 2
A_Q_W = A_HEADS * HEAD_DIM
A_KV_W = A_KV_HEADS * HEAD_DIM
B_W = B_HEADS * HEAD_DIM
AB_IN_W = A_Q_W + 2 * A_KV_W + 3 * B_W
AB_MIX_W = A_Q_W + B_W
C_IN_W = C_Q_RANK + C_KV_RANK + C_ROPE

kernel_name = 'chunk_streaming_hybrid_swa_band_mla'


def layer_norm(x, g, b):
    xf = x.astype(jnp.float32)
    mu = jnp.mean(xf, -1, keepdims=True)
    var = jnp.mean(jnp.square(xf - mu), -1, keepdims=True)
    return ((xf - mu) * lax.rsqrt(var + LN_EPS) * g.astype(jnp.float32) + b.astype(jnp.float32)).astype(x.dtype)


def rms_norm(x, g):
    xf = x.astype(jnp.float32)
    return (xf * lax.rsqrt(jnp.mean(jnp.square(xf), -1, keepdims=True) + RMS_EPS) * g.astype(jnp.float32)).astype(x.dtype)


def rope(x, pos0):
    t, d = x.shape[1], x.shape[-1]
    half = d // 2
    inv = ROPE_THETA ** (-jnp.arange(half, dtype=jnp.float32) * (2.0 / d))
    ang = (jnp.arange(t, dtype=jnp.float32) + pos0)[:, None] * inv[None, :]
    cos = jnp.cos(ang)[None, :, None, :]
    sin = jnp.sin(ang)[None, :, None, :]
    xf = x.astype(jnp.float32)
    x1, x2 = xf[..., :half], xf[..., half:]
    return jnp.concatenate([x1 * cos - x2 * sin, x2 * cos + x1 * sin], -1).astype(x.dtype)


def keep_newest(past, new, cap):
    full = jnp.concatenate([past, new], 1)
    return full[:, -min(cap, full.shape[1]):]


def rel_position_bias(table, band_past):
    r = jnp.arange(CHUNK)[:, None]
    m = jnp.arange(band_past + CHUNK)[None, :]
    idx = jnp.clip(band_past + r - m, -REL_CLIP, REL_CLIP) + REL_CLIP
    return table[:, idx][:, None]


def band_attention(q, k_past, v_past, k_new, v_new, band_past, bias=None, sinks=None):
    b, t, nkv, g, d = q.shape
    n_past = k_past.shape[1]
    nc = -(-t // CHUNK)
    tp = nc * CHUNK
    pad_l = band_past - n_past
    pad_p = ((0, 0), (pad_l, 0), (0, 0), (0, 0))
    pad_n = ((0, 0), (0, tp - t), (0, 0), (0, 0))
    k_all = jnp.concatenate([jnp.pad(k_past, pad_p), jnp.pad(k_new, pad_n)], 1)
    v_all = jnp.concatenate([jnp.pad(v_past, pad_p), jnp.pad(v_new, pad_n)], 1)
    j = jnp.arange(band_past + tp)
    valid = (j >= pad_l) & (j < band_past + t)
    q_blocks = jnp.pad(q, ((0, 0), (0, tp - t), (0, 0), (0, 0), (0, 0))).reshape(b, nc, CHUNK, nkv, g, d).swapaxes(0, 1)
    lb = band_past + CHUNK
    scale = d ** -0.5

    def one_chunk(args):
        c, qc = args
        start = c * CHUNK
        kb = lax.dynamic_slice_in_dim(k_all, start, lb, axis=1)
        vb = lax.dynamic_slice_in_dim(v_all, start, lb, axis=1)
        vm = lax.dynamic_slice_in_dim(valid, start, lb)
        s = jnp.einsum('bckgd,blkd->bkgcl', qc, kb).astype(jnp.float32) * scale
        if bias is not None:
            s = s + bias.astype(jnp.float32)
        s = jnp.where(vm, s, NEG_INF)
        m = jnp.max(s, -1, keepdims=True)
        if sinks is not None:
            sk = sinks.astype(jnp.float32)[None, :, :, None, None]
            m = jnp.maximum(m, sk)
        e = jnp.exp(s - m)
        den = jnp.sum(e, -1, keepdims=True)
        if sinks is not None:
            den = den + jnp.exp(sk - m)
        return jnp.einsum('bkgcl,blkd->bckgd', (e / den).astype(vb.dtype), vb)

    out = lax.map(one_chunk, (jnp.arange(nc), q_blocks))
    return out.swapaxes(0, 1).reshape(b, tp, nkv * g * d)[:, :t]


def chunk_causal_attention(q, k, v, q_pos0):
    b, t, h, dq = q.shape
    s_len = k.shape[1]
    blk = min(Q_BLOCK, t)
    nb = -(-t // blk)
    tp = nb * blk
    q_blocks = jnp.pad(q, ((0, 0), (0, tp - t), (0, 0), (0, 0))).reshape(b, nb, blk, h, dq).swapaxes(0, 1)
    q_chunk = ((q_pos0 + jnp.arange(tp)) // CHUNK).reshape(nb, blk)
    k_chunk = jnp.arange(s_len) // CHUNK
    scale = dq ** -0.5

    def one_block(args):
        qb, qc = args
        s = jnp.einsum('bqhd,bkhd->bhqk', qb, k).astype(jnp.float32) * scale
        s = jnp.where(k_chunk[None, :] <= qc[:, None], s, NEG_INF)
        p = jax.nn.softmax(s, axis=-1).astype(v.dtype)
        return jnp.einsum('bhqk,bkhd->bqhd', p, v)

    out = lax.map(one_block, (q_blocks, q_chunk))
    return out.swapaxes(0, 1).reshape(b, tp, h * v.shape[-1])[:, :t]


def mixer_ab(x, pos0, past_ak, past_av, past_bk, past_bv, w_in, sinks, rel_bias, w_out):
    b, t, _ = x.shape
    h = x @ w_in
    o1 = A_Q_W
    o2 = o1 + A_KV_W
    o3 = o2 + A_KV_W
    o4 = o3 + B_W
    o5 = o4 + B_W
    qa = rope(h[..., :o1].reshape(b, t, A_HEADS, HEAD_DIM), pos0).reshape(b, t, A_KV_HEADS, A_GROUP, HEAD_DIM)
    ka = rope(h[..., o1:o2].reshape(b, t, A_KV_HEADS, HEAD_DIM), pos0)
    va = h[..., o2:o3].reshape(b, t, A_KV_HEADS, HEAD_DIM)
    qb = h[..., o3:o4].reshape(b, t, B_HEADS, 1, HEAD_DIM)
    kb = h[..., o4:o5].reshape(b, t, B_HEADS, HEAD_DIM)
    vb = h[..., o5:].reshape(b, t, B_HEADS, HEAD_DIM)
    out_a = band_attention(qa, past_ak, past_av, ka, va, WINDOW, sinks=sinks.reshape(A_KV_HEADS, A_GROUP))
    out_b = band_attention(qb, past_bk, past_bv, kb, vb, B_BAND_PAST, bias=rel_position_bias(rel_bias, B_BAND_PAST))
    out = jnp.concatenate([out_a, out_b], -1) @ w_out
    states = (keep_newest(past_ak, ka, WINDOW), keep_newest(past_av, va, WINDOW),
              keep_newest(past_bk, kb, B_BAND_PAST), keep_newest(past_bv, vb, B_BAND_PAST))
    return out, states


def mixer_c(x, pos0, past_ckv, past_kr, w_in, g_q, w_q_b, g_kv, w_kv_b, w_out):
    b, t, _ = x.shape
    h = x @ w_in
    cq = rms_norm(h[..., :C_Q_RANK], g_q)
    ckv = rms_norm(h[..., C_Q_RANK:C_Q_RANK + C_KV_RANK], g_kv)
    kr = rope(h[..., C_Q_RANK + C_KV_RANK:][:, :, None, :], pos0)[:, :, 0]
    q = (cq @ w_q_b).reshape(b, t, C_HEADS, C_NOPE + C_ROPE)
    q = jnp.concatenate([q[..., :C_NOPE], rope(q[..., C_NOPE:], pos0)], -1)
    ckv_all = jnp.concatenate([past_ckv, ckv], 1)
    kr_all = jnp.concatenate([past_kr, kr], 1)
    s_len = ckv_all.shape[1]
    kv = (ckv_all @ w_kv_b).reshape(b, s_len, C_HEADS, C_NOPE + C_V)
    k = jnp.concatenate([kv[..., :C_NOPE], jnp.broadcast_to(kr_all[:, :, None, :], (b, s_len, C_HEADS, C_ROPE))], -1)
    o = chunk_causal_attention(q, k, kv[..., C_NOPE:], pos0)
    return o @ w_out, (ckv, kr)


def sq_relu_mlp(x, w_up, w_down):
    return jnp.square(jax.nn.relu(x @ w_up)) @ w_down


def run_trunk(x, p, pos0, past_a_k, past_a_v, past_b_k, past_b_v, past_c_kv, past_c_kr, w):
    a_k, a_v, b_k, b_v, c_kv, c_kr = [], [], [], [], [], []
    for i in range(DEPTH):
        j = i // 2
        if i % 2 == 0:
            mix, (ak, av, bk, bv) = mixer_ab(x, pos0, past_a_k[j], past_a_v[j], past_b_k[j], past_b_v[j],
                                             w['w_in_ab'][j], w['sinks_a'][j], w['rel_bias_b'][j], w['w_out_ab'][j])
            a_k.append(ak)
            a_v.append(av)
            b_k.append(bk)
            b_v.append(bv)
        else:
            mix, (ckv, ckr) = mixer_c(x, pos0, past_c_kv[j], past_c_kr[j], w['w_in_c'][j], w['g_q_c'][j],
                                      w['w_q_b_c'][j], w['g_kv_c'][j], w['w_kv_b_c'][j], w['w_out_c'][j])
            c_kv.append(ckv)
            c_kr.append(ckr)
        x = layer_norm(DEEPNORM_ALPHA * x + mix, w['ln1_g'][i], w['ln1_b'][i])
        x = layer_norm(DEEPNORM_ALPHA * x + sq_relu_mlp(x, w['w_mlp_up'][i], w['w_mlp_down'][i]),
                       w['ln2_g'][i], w['ln2_b'][i])
        gate = jax.nn.sigmoid((x @ w['w_ple_gate'][i] + w['b_ple_gate'][i]).astype(jnp.float32)).astype(x.dtype)
        x = x + gate * (p[i] @ w['w_ple'][i])
    return x, jnp.stack(a_k), jnp.stack(a_v), jnp.stack(b_k), jnp.stack(b_v), jnp.stack(c_kv), jnp.stack(c_kr)


def setup_inputs(seed: int = 0) -> dict:
    key = jax.random.key(seed)
    ks = jax.random.split(key, 32)

    def nrm(k, shape, scale=1.0):
        return jax.random.normal(k, shape, jnp.float32) * scale

    a_cache = min(WINDOW, PAST_LEN)
    b_cache = min(B_BAND_PAST, PAST_LEN)
    return {
        'x_prompt': nrm(ks[0], (BATCH, SEQ, D_MODEL)),
        'x_sample': nrm(ks[1], (DEC_BATCH, DEC_SEQ, D_MODEL)),
        'cache_a_k': nrm(ks[2], (N_AB_LAYERS, DEC_BATCH, a_cache, A_KV_HEADS, HEAD_DIM)),
        'cache_a_v': nrm(ks[3], (N_AB_LAYERS, DEC_BATCH, a_cache, A_KV_HEADS, HEAD_DIM)),
        'cache_b_k': nrm(ks[4], (N_AB_LAYERS, DEC_BATCH, b_cache, B_HEADS, HEAD_DIM)),
        'cache_b_v': nrm(ks[5], (N_AB_LAYERS, DEC_BATCH, b_cache, B_HEADS, HEAD_DIM)),
        'cache_c_kv': nrm(ks[6], (N_C_LAYERS, DEC_BATCH, PAST_LEN, C_KV_RANK)),
        'cache_c_krope': nrm(ks[7], (N_C_LAYERS, DEC_BATCH, PAST_LEN, C_ROPE)),
        'p_prompt': nrm(ks[8], (DEPTH, BATCH, SEQ, PLE_DIM)),
        'p_sample': nrm(ks[9], (DEPTH, DEC_BATCH, DEC_SEQ, PLE_DIM)),
        'w_in_ab': nrm(ks[10], (N_AB_LAYERS, D_MODEL, AB_IN_W), D_MODEL ** -0.5),
        'sinks_a': nrm(ks[11], (N_AB_LAYERS, A_HEADS), 0.5),
        'rel_bias_b': nrm(ks[12], (N_AB_LAYERS, B_HEADS, 2 * REL_CLIP + 1), 0.1),
        'w_out_ab': nrm(ks[13], (N_AB_LAYERS, AB_MIX_W, D_MODEL), DEEPNORM_BETA * AB_MIX_W ** -0.5),
        'w_in_c': nrm(ks[14], (N_C_LAYERS, D_MODEL, C_IN_W), D_MODEL ** -0.5),
        'g_q_c': 1.0 + nrm(ks[15], (N_C_LAYERS, C_Q_RANK), 0.02),
        'w_q_b_c': nrm(ks[16], (N_C_LAYERS, C_Q_RANK, C_HEADS * (C_NOPE + C_ROPE)), C_Q_RANK ** -0.5),
        'g_kv_c': 1.0 + nrm(ks[17], (N_C_LAYERS, C_KV_RANK), 0.02),
        'w_kv_b_c': nrm(ks[18], (N_C_LAYERS, C_KV_RANK, C_HEADS * (C_NOPE + C_V)), C_KV_RANK ** -0.5),
        'w_out_c': nrm(ks[19], (N_C_LAYERS, C_HEADS * C_V, D_MODEL), DEEPNORM_BETA * (C_HEADS * C_V) ** -0.5),
        'ln1_g': 1.0 + nrm(ks[20], (DEPTH, D_MODEL), 0.02),
        'ln1_b': nrm(ks[21], (DEPTH, D_MODEL), 0.02),
        'ln2_g': 1.0 + nrm(ks[22], (DEPTH, D_MODEL), 0.02),
        'ln2_b': nrm(ks[23], (DEPTH, D_MODEL), 0.02),
        'w_mlp_up': nrm(ks[24], (DEPTH, D_MODEL, D_FF), D_MODEL ** -0.5),
        'w_mlp_down': nrm(ks[25], (DEPTH, D_FF, D_MODEL), DEEPNORM_BETA * D_FF ** -0.5),
        'w_ple_gate': nrm(ks[26], (DEPTH, D_MODEL, D_MODEL), D_MODEL ** -0.5),
        'b_ple_gate': nrm(ks[27], (DEPTH, D_MODEL), 0.02),
        'w_ple': nrm(ks[28], (DEPTH, PLE_DIM, D_MODEL), PLE_DIM ** -0.5),
    }


def reference(x_prompt, x_sample, cache_a_k, cache_a_v, cache_b_k, cache_b_v, cache_c_kv, cache_c_krope,
              p_prompt, p_sample, w_in_ab, sinks_a, rel_bias_b, w_out_ab, w_in_c, g_q_c, w_q_b_c, g_kv_c,
              w_kv_b_c, w_out_c, ln1_g, ln1_b, ln2_g, ln2_b, w_mlp_up, w_mlp_down, w_ple_gate, b_ple_gate, w_ple):
    w = {
        'w_in_ab': w_in_ab, 'sinks_a': sinks_a, 'rel_bias_b': rel_bias_b, 'w_out_ab': w_out_ab,
        'w_in_c': w_in_c, 'g_q_c': g_q_c, 'w_q_b_c': w_q_b_c, 'g_kv_c': g_kv_c, 'w_kv_b_c': w_kv_b_c,
        'w_out_c': w_out_c, 'ln1_g': ln1_g, 'ln1_b': ln1_b, 'ln2_g': ln2_g, 'ln2_b': ln2_b,
        'w_mlp_up': w_mlp_up, 'w_mlp_down': w_mlp_down, 'w_ple_gate': w_ple_gate, 'b_ple_gate': b_ple_gate,
        'w_ple': w_ple,
    }
    bp = x_prompt.shape[0]
    dt = x_prompt.dtype
    empty_a = jnp.zeros((N_AB_LAYERS, bp, 0, A_KV_HEADS, HEAD_DIM), dt)
    empty_b = jnp.zeros((N_AB_LAYERS, bp, 0, B_HEADS, HEAD_DIM), dt)
    empty_c = jnp.zeros((N_C_LAYERS, bp, 0, C_KV_RANK), dt)
    empty_r = jnp.zeros((N_C_LAYERS, bp, 0, C_ROPE), dt)
    y_prompt, pa_k, pa_v, pb_k, pb_v, pc_kv, pc_kr = run_trunk(
        x_prompt, p_prompt, 0, empty_a, empty_a, empty_b, empty_b, empty_c, empty_r, w)
    y_sample, sa_k, sa_v, sb_k, sb_v, sc_kv, sc_kr = run_trunk(
        x_sample, p_sample, PAST_LEN, cache_a_k, cache_a_v, cache_b_k, cache_b_v, cache_c_kv, cache_c_krope, w)
    return (y_prompt, y_sample, pa_k, pa_v, pb_k, pb_v, pc_kv, pc_kr, sa_k, sa_v, sb_k, sb_v, sc_kv, sc_kr)
```

```cpp
#include <hip/hip_runtime.h>
#include <hip/hip_cooperative_groups.h>
#include <cstdio>
#include <cstdint>
namespace cg = cooperative_groups;
namespace pg8 {
#define PG8_LAS __attribute__((address_space(3)))
typedef unsigned short bf16_t;
typedef short bf16x8 __attribute__((ext_vector_type(8)));
typedef float f32x4 __attribute__((ext_vector_type(4)));
typedef unsigned u32x4 __attribute__((ext_vector_type(4)));
constexpr int BM = 256, BK = 64, HALF = 128, HTB = HALF * BK * 2  , STAGE_BYTES = 8 * HTB, NXCD = 8, WGM = 8;

__host__ __device__ __forceinline__ int lds_byte(int r, int c) { const int st = (r >> 4) * 2 + (c >> 5), rr = r & 15, cc = c & 31, ob = rr * 64 + cc * 2; return st * 1024 + (ob ^ (((ob >> 9) & 1) << 5)); }
__host__ __device__ __forceinline__ void stage_rc(int b, int& R, int& C) { const int st = b / 1024, sb = b % 1024, swz = sb ^ (((sb >> 9) & 1) << 5); R = (st >> 1) * 16 + swz / 64; C = (st & 1) * 32 + (swz % 64) / 2; }
__host__ __device__ __forceinline__ int perm32(int rho) { const int n = rho >> 4, i = rho & 15; return 8 * (i >> 2) + 4 * n + (i & 3); }

struct Unit { int pm, pn, kt0, knt; };
struct Gemm { const bf16_t* A; const bf16_t* Bt; int M, N, K; };

struct StaticOrder {
    int nM, nN, nwg, G, c, nt;
    __host__ __device__ void init(int M, int N, int K, int G_, int c_) { nM = M / BM; nN = N / BM; nwg = nM * nN; G = G_; c = c_; nt = K / BK; }
    __host__ __device__ bool next(int i, Unit& u) const {
        const long L = (long)i * G + c; if (L >= nwg) return false;
        int wgid = (int)L; { const int q = nwg / NXCD, r = nwg % NXCD, xcd = wgid % NXCD, off = wgid / NXCD; wgid = (xcd < r ? xcd * (q + 1) : r * (q + 1) + (xcd - r) * q) + off; }
        const int nig = WGM * nN, gid = wgid / nig, fm = gid * WGM, gsz = (nM - fm) < WGM ? (nM - fm) : WGM;
        u.pm = fm + ((wgid % nig) % gsz); u.pn = (wgid % nig) / gsz; u.kt0 = 0; u.knt = nt; return true;
    }
    __device__ __forceinline__ void a_ready(const Unit&) const {}
    __device__ __forceinline__ void done(const Unit&) const {}
};

struct SplitOrder {
    StaticOrder P; int nMp, nMs, S, nreg;
    __host__ __device__ void init(int Mp, int Ms, int N, int K, int S_, int G_, int c_) { P.init(Mp, N, K, G_, c_); nMp = Mp / BM; nMs = Ms / BM; S = S_; nreg = (P.nwg + G_ - 1) / G_; }
    __host__ __device__ bool next(int i, Unit& u) const {
        Unit t; t.pm = 0; t.pn = 0; t.kt0 = 0; t.knt = P.nt;
        const bool reg = (i < nreg) && P.next(i, t);
        const int i2 = i < nreg ? nreg : i;
        const long j = (long)(i2 - nreg) * P.G + P.c; const bool ok2 = j < (long)nMs * P.nN * S;
        const int tix = (int)(j / S), sp = (int)(j % S), kn = P.nt / S;
        u.pm = reg ? t.pm : nMp + tix / P.nN; u.pn = reg ? t.pn : tix % P.nN; u.kt0 = reg ? 0 : sp * kn; u.knt = reg ? P.nt : kn;
        return reg || ok2;
    }
    __device__ __forceinline__ void a_ready(const Unit&) const {}
    __device__ __forceinline__ void done(const Unit&) const {}
};
__device__ __forceinline__ unsigned cvt_pk_bf16(float lo, float hi) { unsigned r; asm volatile("v_cvt_pk_bf16_f32 %0, %1, %2" : "=v"(r) : "v"(lo), "v"(hi)); return r; }
typedef float f32x2 __attribute__((ext_vector_type(2)));
typedef unsigned u32x2 __attribute__((ext_vector_type(2)));
template <int ACT  > struct EpiBf16 {
    static constexpr bool PERM = true, AFTER_DRAIN = false;
    bf16_t* O; int ldc;
    __device__ __forceinline__ void operator()(const f32x4 (&acc)[2][2][4][2], const Unit& u, int wr, int wc, int fr, int fq) const {
        const int row0 = u.pm * BM + wr * 64 + fr, col0 = u.pn * BM + wc * 32 + 8 * fq;
#pragma unroll
        for (int ai = 0; ai < 2; ++ai)
#pragma unroll
            for (int m = 0; m < 4; ++m) { bf16_t* rowp = O + (size_t)(row0 + ai * HALF + m * 16) * ldc + col0;
#pragma unroll
                for (int bj = 0; bj < 2; ++bj) { f32x4 v0 = acc[ai][bj][m][0], v1 = acc[ai][bj][m][1];
                    if (ACT == 2) {
#pragma unroll
                        for (int j = 0; j < 4; ++j) { const float a = fmaxf(v0[j], 0.f), b = fmaxf(v1[j], 0.f); v0[j] = a * a; v1[j] = b * b; } }
                    u32x4 w; w.x = cvt_pk_bf16(v0[0], v0[1]); w.y = cvt_pk_bf16(v0[2], v0[3]); w.z = cvt_pk_bf16(v1[0], v1[1]); w.w = cvt_pk_bf16(v1[2], v1[3]);
                    *(u32x4*)(rowp + bj * HALF) = w; } }
    }
};
__device__ __forceinline__ float bf_lo(unsigned w) { return __uint_as_float(w << 16); }
__device__ __forceinline__ float bf_hi(unsigned w) { return __uint_as_float(w & 0xffff0000u); }
struct EpiBf16P {
    static constexpr bool PERM = true, AFTER_DRAIN = false;
    bf16_t* O; int ldc; float* Tp; int ldp, full_nt, row_base, part_rows;
    __device__ __forceinline__ void operator()(const f32x4 (&acc)[2][2][4][2], const Unit& u, int wr, int wc, int fr, int fq) const {
        const int row0 = u.pm * BM + wr * 64 + fr, col0 = u.pn * BM + wc * 32 + 8 * fq;
        if (u.knt != full_nt) {
            float* tp = Tp + ((size_t)(u.kt0 / u.knt) * part_rows + (row0 - row_base)) * ldp + col0;
#pragma unroll
            for (int ai = 0; ai < 2; ++ai)
#pragma unroll
                for (int m = 0; m < 4; ++m)
#pragma unroll
                    for (int bj = 0; bj < 2; ++bj) { float* p = tp + (size_t)(ai * HALF + m * 16) * ldp + bj * HALF; *(f32x4*)p = acc[ai][bj][m][0]; *(f32x4*)(p + 4) = acc[ai][bj][m][1]; }
            return; }
#pragma unroll
        for (int ai = 0; ai < 2; ++ai)
#pragma unroll
            for (int m = 0; m < 4; ++m) { bf16_t* rowp = O + (size_t)(row0 + ai * HALF + m * 16) * ldc + col0;
#pragma unroll
                for (int bj = 0; bj < 2; ++bj) { const f32x4 v0 = acc[ai][bj][m][0], v1 = acc[ai][bj][m][1];
                    u32x4 w; w.x = cvt_pk_bf16(v0[0], v0[1]); w.y = cvt_pk_bf16(v0[2], v0[3]); w.z = cvt_pk_bf16(v1[0], v1[1]); w.w = cvt_pk_bf16(v1[2], v1[3]);
                    *(u32x4*)(rowp + bj * HALF) = w; } }
    }
};
typedef float f32x2e __attribute__((ext_vector_type(2)));
__device__ __forceinline__ void row_mr(const float* stats, int row, float& mean, float& rstd) { const f32x2e st = *(const f32x2e*)(stats + 2 * (size_t)row); mean = st.x * (1.0f / 2048.0f); const float var = st.y * (1.0f / 2048.0f) - mean * mean; rstd = 1.0f / sqrtf(fmaxf(var, 0.f) + 1e-5f); }
struct EpiUpLn {
    static constexpr bool PERM = true, AFTER_DRAIN = false;
    bf16_t* O; int ldc; const float* stats; const float* colc; const float* cold;
    __device__ __forceinline__ void operator()(const f32x4 (&acc)[2][2][4][2], const Unit& u, int wr, int wc, int fr, int fq) const {
        const int row0 = u.pm * BM + wr * 64 + fr, col0 = u.pn * BM + wc * 32 + 8 * fq;
        f32x4 cv[2][2], dv[2][2];
#pragma unroll
        for (int bj = 0; bj < 2; ++bj)
#pragma unroll
            for (int n = 0; n < 2; ++n) { cv[bj][n] = *(const f32x4*)(colc + col0 + bj * HALF + 4 * n); dv[bj][n] = *(const f32x4*)(cold + col0 + bj * HALF + 4 * n); }
#pragma unroll
        for (int ai = 0; ai < 2; ++ai)
#pragma unroll
            for (int m = 0; m < 4; ++m) { const int row = row0 + ai * HALF + m * 16; float mean, rstd; row_mr(stats, row, mean, rstd);
                bf16_t* rowp = O + (size_t)row * ldc + col0;
#pragma unroll
                for (int bj = 0; bj < 2; ++bj) { float r[8];
#pragma unroll
                    for (int j = 0; j < 8; ++j) { const float v = rstd * (acc[ai][bj][m][j >> 2][j & 3] - mean * cv[bj][j >> 2][j & 3]) + dv[bj][j >> 2][j & 3]; const float a = fmaxf(v, 0.f); r[j] = a * a; }
                    u32x4 w; w.x = cvt_pk_bf16(r[0], r[1]); w.y = cvt_pk_bf16(r[2], r[3]); w.z = cvt_pk_bf16(r[4], r[5]); w.w = cvt_pk_bf16(r[6], r[7]);
                    *(u32x4*)(rowp + bj * HALF) = w; } }
    }
};
template <bool LN_IN> struct EpiResid {
    static constexpr bool PERM = true, AFTER_DRAIN = false;
    const bf16_t* X; bf16_t* T; int ldc; float alpha; float* Tp; int full_nt, row_base, part_rows; const float* stats_in; const float* g; const float* bta; float* stats_out;
    __device__ __forceinline__ void operator()(const f32x4 (&acc)[2][2][4][2], const Unit& u, int wr, int wc, int fr, int fq) const {
        const int row0 = u.pm * BM + wr * 64 + fr, col0 = u.pn * BM + wc * 32 + 8 * fq;
        if (u.knt != full_nt) {
            float* tp = Tp + ((size_t)(u.kt0 / u.knt) * part_rows + (row0 - row_base)) * ldc + col0;
#pragma unroll
            for (int ai = 0; ai < 2; ++ai)
#pragma unroll
                for (int m = 0; m < 4; ++m)
#pragma unroll
                    for (int bj = 0; bj < 2; ++bj) { float* p = tp + (size_t)(ai * HALF + m * 16) * ldc + bj * HALF; *(f32x4*)p = acc[ai][bj][m][0]; *(f32x4*)(p + 4) = acc[ai][bj][m][1]; }
            return; }
        f32x4 gv[2][2], bv[2][2];
        if (LN_IN) {
#pragma unroll
            for (int bj = 0; bj < 2; ++bj)
#pragma unroll
                for (int n = 0; n < 2; ++n) { gv[bj][n] = *(const f32x4*)(g + col0 + bj * HALF + 4 * n); bv[bj][n] = *(const f32x4*)(bta + col0 + bj * HALF + 4 * n); } }
#pragma unroll
        for (int ai = 0; ai < 2; ++ai)
#pragma unroll
            for (int m = 0; m < 4; ++m) { const int row = row0 + ai * HALF + m * 16; const size_t off = (size_t)row * ldc + col0;
                float mean = 0.f, rstd = 1.f; if (LN_IN) row_mr(stats_in, row, mean, rstd);
                u32x4 x[2];
#pragma unroll
                for (int bj = 0; bj < 2; ++bj) x[bj] = *(const u32x4*)(X + off + bj * HALF);
                float s1 = 0.f, s2 = 0.f;
#pragma unroll
                for (int bj = 0; bj < 2; ++bj) { float xs[8] = {bf_lo(x[bj].x), bf_hi(x[bj].x), bf_lo(x[bj].y), bf_hi(x[bj].y), bf_lo(x[bj].z), bf_hi(x[bj].z), bf_lo(x[bj].w), bf_hi(x[bj].w)}; float t[8];
#pragma unroll
                    for (int j = 0; j < 8; ++j) { float xv = xs[j]; if (LN_IN) xv = (xv - mean) * rstd * gv[bj][j >> 2][j & 3] + bv[bj][j >> 2][j & 3];
                        t[j] = xv * alpha + acc[ai][bj][m][j >> 2][j & 3]; s1 += t[j]; s2 += t[j] * t[j]; }
                    u32x4 w; w.x = cvt_pk_bf16(t[0], t[1]); w.y = cvt_pk_bf16(t[2], t[3]); w.z = cvt_pk_bf16(t[4], t[5]); w.w = cvt_pk_bf16(t[6], t[7]);
                    *(u32x4*)(T + off + bj * HALF) = w; }
                s1 += __shfl_xor(s1, 16); s1 += __shfl_xor(s1, 32); s2 += __shfl_xor(s2, 16); s2 += __shfl_xor(s2, 32);
                if (fq == 0) { __hip_atomic_fetch_add(stats_out + 2 * (size_t)row, s1, __ATOMIC_RELAXED, __HIP_MEMORY_SCOPE_AGENT); __hip_atomic_fetch_add(stats_out + 2 * (size_t)row + 1, s2, __ATOMIC_RELAXED, __HIP_MEMORY_SCOPE_AGENT); }
                if (m & 1) asm volatile("" ::: "memory"); }
    }
};
struct EpiGate {
    static constexpr bool PERM = true, AFTER_DRAIN = false;
    const float* bg; const bf16_t* ple; const bf16_t* X; bf16_t* Xo; float* Yo; int ldc; float* Tp; int full_nt, row_base, part_rows; const float* stats; const float* g; const float* bta; const float* colc; const float* cold;
    __device__ __forceinline__ void operator()(const f32x4 (&acc)[2][2][4][2], const Unit& u, int wr, int wc, int fr, int fq) const {
        const int row0 = u.pm * BM + wr * 64 + fr, col0 = u.pn * BM + wc * 32 + 8 * fq;
        if (u.knt != full_nt) {
            float* tp = Tp + ((size_t)(u.kt0 / u.knt) * part_rows + (row0 - row_base)) * ldc + col0;
#pragma unroll
            for (int ai = 0; ai < 2; ++ai)
#pragma unroll
                for (int m = 0; m < 4; ++m)
#pragma unroll
                    for (int bj = 0; bj < 2; ++bj) { float* p = tp + (size_t)(ai * HALF + m * 16) * ldc + bj * HALF; *(f32x4*)p = acc[ai][bj][m][0]; *(f32x4*)(p + 4) = acc[ai][bj][m][1]; }
            return; }
#pragma unroll
        for (int bj = 0; bj < 2; ++bj) {
            f32x4 gv[2], bv[2], cv[2], dv[2];
#pragma unroll
            for (int n = 0; n < 2; ++n) { const int c = col0 + bj * HALF + 4 * n; gv[n] = *(const f32x4*)(g + c); bv[n] = *(const f32x4*)(bta + c); cv[n] = *(const f32x4*)(colc + c); dv[n] = *(const f32x4*)(cold + c) + *(const f32x4*)(bg + c); }
#pragma unroll
            for (int ai = 0; ai < 2; ++ai)
#pragma unroll
                for (int m = 0; m < 4; ++m) { const int row = row0 + ai * HALF + m * 16; const size_t o = (size_t)row * ldc + col0 + bj * HALF;
                    float mean, rstd; row_mr(stats, row, mean, rstd);
                    const u32x4 xw = *(const u32x4*)(X + o), pw = *(const u32x4*)(ple + o);
                    const float xs[8] = {bf_lo(xw.x), bf_hi(xw.x), bf_lo(xw.y), bf_hi(xw.y), bf_lo(xw.z), bf_hi(xw.z), bf_lo(xw.w), bf_hi(xw.w)};
                    const float ps[8] = {bf_lo(pw.x), bf_hi(pw.x), bf_lo(pw.y), bf_hi(pw.y), bf_lo(pw.z), bf_hi(pw.z), bf_lo(pw.w), bf_hi(pw.w)};
                    float r[8];
#pragma unroll
                    for (int j = 0; j < 8; ++j) { const float v = rstd * (acc[ai][bj][m][j >> 2][j & 3] - mean * cv[j >> 2][j & 3]) + dv[j >> 2][j & 3];
                        const float xv = (xs[j] - mean) * rstd * gv[j >> 2][j & 3] + bv[j >> 2][j & 3];
                        const float gt_ = __builtin_amdgcn_rcpf(1.0f + __builtin_amdgcn_exp2f(-1.44269504089f * v)); r[j] = xv + gt_ * ps[j]; }
                    if (Xo) { u32x4 w; w.x = cvt_pk_bf16(r[0], r[1]); w.y = cvt_pk_bf16(r[2], r[3]); w.z = cvt_pk_bf16(r[4], r[5]); w.w = cvt_pk_bf16(r[6], r[7]); *(u32x4*)(Xo + o) = w; }
                    else { *(f32x4*)(Yo + o) = (f32x4){r[0], r[1], r[2], r[3]}; *(f32x4*)(Yo + o + 4) = (f32x4){r[4], r[5], r[6], r[7]}; }
                    if (m & 1) asm volatile("" ::: "memory"); } }
    }
};
template <class Epi, class Sched, bool ALIGN_EPI = false, bool SP2 = false>
__device__ __forceinline__ void gemm_phase(PG8_LAS unsigned char* lds, const Gemm g, const Sched& S, const Epi& E) {
    int tid_ = threadIdx.x; asm volatile("" : "+v"(tid_));
    const int tid = tid_, wid = __builtin_amdgcn_readfirstlane(tid >> 6), lane = tid & 63, wr = wid >> 2, wc = wid & 3, fr = lane & 15, fq = lane >> 4;
    const int K = g.K, nt = K / BK;
    unsigned voffA[2], voffB[2];
#pragma unroll
    for (int i = 0; i < 2; ++i) { int R, C; stage_rc(tid * 16 + i * 8192, R, C); const int Rb = Epi::PERM ? ((R & ~31) + perm32(R & 31)) : R;
        voffA[i] = (unsigned)(R * K + C) * 2u; voffB[i] = (unsigned)(Rb * K + C) * 2u; }
    const size_t kstep = (size_t)(BK * 2);
    const size_t hstep = (size_t)HALF * K * 2;
    const size_t tstep = 2 * hstep;
    const unsigned ldsw = (unsigned)wid * 1024u;
    const int aoff = lds_byte(wr * 64 + fr, fq * 8), boff = lds_byte(wc * 32 + fr, fq * 8);
#define PG8_SA(b, h) (((b) * 2 + (h)) * HTB)
#define PG8_SB(b, h) ((4 + (b) * 2 + (h)) * HTB)
#define PG8_STAGE(bufoff, gbase, voff) do { _Pragma("unroll") for (int _i = 0; _i < 2; ++_i) \
        __builtin_amdgcn_global_load_lds((const unsigned*)((const char*)(gbase) + (voff)[_i]), (PG8_LAS unsigned*)(lds + (bufoff) + ldsw + _i * 8192), 16, 0, 0); } while (0)
#define PG8_LDA(dst, b, h) do { _Pragma("unroll") for (int m = 0; m < 4; ++m) _Pragma("unroll") for (int k = 0; k < 2; ++k) dst[m][k] = *(const PG8_LAS bf16x8*)(lds + PG8_SA(b, h) + aoff + m * 2048 + k * 1024); } while (0)
#define PG8_LDB(dst, b, h) do { _Pragma("unroll") for (int n = 0; n < 2; ++n) _Pragma("unroll") for (int k = 0; k < 2; ++k) dst[n][k] = *(const PG8_LAS bf16x8*)(lds + PG8_SB(b, h) + boff + n * 2048 + k * 1024); } while (0)
#define PG8_MMA(ai, bj, At, Bt) do { __builtin_amdgcn_s_setprio(1); _Pragma("unroll") for (int m = 0; m < 4; ++m) _Pragma("unroll") for (int n = 0; n < 2; ++n) _Pragma("unroll") for (int k = 0; k < 2; ++k) \
        acc[ai][bj][m][n] = __builtin_amdgcn_mfma_f32_16x16x32_bf16(Bt[n][k], At[m][k], acc[ai][bj][m][n], 0, 0, 0); __builtin_amdgcn_s_setprio(0); } while (0)
#define PG8_WAIT_V(n) asm volatile("s_waitcnt vmcnt(" #n ")" ::: "memory")
#define PG8_WAIT_L(n) asm volatile("s_waitcnt lgkmcnt(" #n ")" ::: "memory")
#define PG8_BAR __builtin_amdgcn_s_barrier()
#define PG8_SCHED __builtin_amdgcn_sched_barrier(0)
    Unit cur, nxt; int ui = 0;
    if (!S.next(0, cur)) return;
    f32x4 acc[2][2][4][2];
#pragma unroll
    for (int a = 0; a < 2; ++a)
#pragma unroll
        for (int b = 0; b < 2; ++b)
#pragma unroll
            for (int m = 0; m < 4; ++m)
#pragma unroll
                for (int n = 0; n < 2; ++n) acc[a][b][m][n] = (f32x4){0.f, 0.f, 0.f, 0.f};
    bf16x8 At[4][2], B0[2][2], B1[2][2];
    const char* cA = (const char*)g.A + (size_t)cur.pm * tstep + (size_t)cur.kt0 * kstep; const char* cB = (const char*)g.Bt + (size_t)cur.pn * tstep + (size_t)cur.kt0 * kstep;
    S.a_ready(cur);
    if constexpr (SP2) {
        PG8_STAGE(PG8_SB(0, 0), cB, voffB); PG8_STAGE(PG8_SB(0, 1), cB + hstep, voffB); PG8_STAGE(PG8_SA(0, 0), cA, voffA); PG8_STAGE(PG8_SA(0, 1), cA + hstep, voffA);
        if (wr == 1) PG8_BAR;
        PG8_WAIT_V(2); PG8_BAR;
        PG8_STAGE(PG8_SB(1, 0), cB + kstep, voffB); PG8_STAGE(PG8_SA(1, 0), cA + kstep, voffA); PG8_STAGE(PG8_SB(1, 1), cB + hstep + kstep, voffB);
        PG8_WAIT_V(6); PG8_BAR;
    } else {
        PG8_STAGE(PG8_SB(0, 0), cB, voffB); PG8_STAGE(PG8_SA(0, 0), cA, voffA); PG8_STAGE(PG8_SB(0, 1), cB + hstep, voffB); PG8_STAGE(PG8_SA(0, 1), cA + hstep, voffA);
        if (wr == 1) PG8_BAR;
        PG8_WAIT_V(4); PG8_BAR;
        PG8_STAGE(PG8_SB(1, 0), cB + kstep, voffB); PG8_STAGE(PG8_SA(1, 0), cA + kstep, voffA); PG8_STAGE(PG8_SB(1, 1), cB + hstep + kstep, voffB);
        PG8_WAIT_V(6); PG8_BAR;
    }
    for (;;) {
        const bool has_next = S.next(ui + 1, nxt);
        const char* nA = has_next ? (const char*)g.A + (size_t)nxt.pm * tstep + (size_t)nxt.kt0 * kstep : cA; const char* nB = has_next ? (const char*)g.Bt + (size_t)nxt.pn * tstep + (size_t)nxt.kt0 * kstep : cB;
        const int unt = cur.knt;
        for (int t = 0; t < unt; t += 2) {
            const bool last = (t == unt - 2);
            const char* a1 = cA + (size_t)(t + 1) * kstep;
            const char* a2 = last ? nA : cA + (size_t)(t + 2) * kstep; const char* b2 = last ? nB : cB + (size_t)(t + 2) * kstep;
            const char* a3 = a2 + kstep; const char* b3 = b2 + kstep;
            if (last && has_next) S.a_ready(nxt);
            if constexpr (SP2) {
            PG8_LDB(B0, 0, 0); PG8_LDB(B1, 0, 1); PG8_SCHED; PG8_LDA(At, 0, 0); PG8_STAGE(PG8_SA(1, 1), a1 + hstep, voffA);
            PG8_WAIT_V(8); PG8_WAIT_L(0); PG8_BAR; PG8_MMA(0, 0, At, B0); PG8_MMA(0, 1, At, B1); PG8_BAR; PG8_SCHED;
            PG8_LDA(At, 0, 1); PG8_STAGE(PG8_SB(0, 0), b2, voffB); PG8_STAGE(PG8_SB(0, 1), b2 + hstep, voffB); PG8_STAGE(PG8_SA(0, 0), a2, voffA);
            PG8_WAIT_V(8); PG8_WAIT_L(0); PG8_BAR; PG8_MMA(1, 0, At, B0); PG8_MMA(1, 1, At, B1); PG8_BAR; PG8_SCHED;
            PG8_LDB(B0, 1, 0); PG8_LDB(B1, 1, 1); PG8_SCHED; PG8_LDA(At, 1, 0); PG8_STAGE(PG8_SA(0, 1), a2 + hstep, voffA);
            PG8_WAIT_V(8); PG8_WAIT_L(0); PG8_BAR; PG8_MMA(0, 0, At, B0); PG8_MMA(0, 1, At, B1); PG8_BAR; PG8_SCHED;
            PG8_LDA(At, 1, 1); PG8_STAGE(PG8_SB(1, 0), b3, voffB); PG8_STAGE(PG8_SB(1, 1), b3 + hstep, voffB); PG8_STAGE(PG8_SA(1, 0), a3, voffA);
            PG8_WAIT_V(8); PG8_WAIT_L(0); PG8_BAR; PG8_MMA(1, 0, At, B0); PG8_MMA(1, 1, At, B1); PG8_BAR; PG8_SCHED;
            } else {
            PG8_LDB(B0, 0, 0); PG8_SCHED; PG8_LDA(At, 0, 0); PG8_STAGE(PG8_SA(1, 1), a1 + hstep, voffA);
            PG8_WAIT_L(8); PG8_BAR; PG8_WAIT_L(0); PG8_MMA(0, 0, At, B0); PG8_BAR; PG8_SCHED;
            PG8_LDB(B1, 0, 1); PG8_STAGE(PG8_SB(0, 0), b2, voffB);
            PG8_BAR; PG8_WAIT_L(0); PG8_MMA(0, 1, At, B1); PG8_BAR;
            PG8_LDA(At, 0, 1); PG8_STAGE(PG8_SA(0, 0), a2, voffA);
            PG8_BAR; PG8_WAIT_L(0); PG8_MMA(1, 0, At, B0); PG8_BAR; PG8_SCHED;
            PG8_STAGE(PG8_SB(0, 1), b2 + hstep, voffB);
            PG8_WAIT_V(6); PG8_BAR; PG8_MMA(1, 1, At, B1); PG8_BAR;
            PG8_LDB(B0, 1, 0); PG8_SCHED; PG8_LDA(At, 1, 0); PG8_STAGE(PG8_SA(0, 1), a2 + hstep, voffA);
            PG8_WAIT_L(8); PG8_BAR; PG8_WAIT_L(0); PG8_MMA(0, 0, At, B0); PG8_BAR; PG8_SCHED;
            PG8_LDB(B1, 1, 1); PG8_STAGE(PG8_SB(1, 0), b3, voffB);
            PG8_BAR; PG8_WAIT_L(0); PG8_MMA(0, 1, At, B1); PG8_BAR;
            PG8_LDA(At, 1, 1); PG8_STAGE(PG8_SA(1, 0), a3, voffA);
            PG8_BAR; PG8_WAIT_L(0); PG8_MMA(1, 0, At, B0); PG8_BAR; PG8_SCHED;
            PG8_STAGE(PG8_SB(1, 1), b3 + hstep, voffB);
            PG8_WAIT_V(6); PG8_BAR; PG8_MMA(1, 1, At, B1); PG8_BAR;
            }
        }
        if constexpr (ALIGN_EPI) { if (wr == 0) PG8_BAR; }
        if constexpr (!Epi::AFTER_DRAIN) { E(acc, cur, wr, wc, fr, fq); S.done(cur); }
        if (!has_next) break;
#pragma unroll
        for (int a = 0; a < 2; ++a)
#pragma unroll
            for (int b = 0; b < 2; ++b)
#pragma unroll
                for (int m = 0; m < 4; ++m)
#pragma unroll
                    for (int n = 0; n < 2; ++n) acc[a][b][m][n] = (f32x4){0.f, 0.f, 0.f, 0.f};
        cur = nxt; cA = nA; cB = nB; ++ui;
        if constexpr (ALIGN_EPI) { if (wr == 1) PG8_BAR; }
    }
    PG8_WAIT_V(0);
    if constexpr (!ALIGN_EPI) { if (wr == 0) PG8_BAR; }
    PG8_BAR;
    if constexpr (Epi::AFTER_DRAIN) { E.fused(acc, cur, wr, wc, fr, fq, lds, wid, lane); S.done(cur); }
#undef PG8_SA
#undef PG8_SB
#undef PG8_STAGE
#undef PG8_LDA
#undef PG8_LDB
#undef PG8_MMA
#undef PG8_WAIT_V
#undef PG8_WAIT_L
#undef PG8_BAR
#undef PG8_SCHED
}
}
#define LAS __attribute__((address_space(3)))
typedef unsigned short bf16;
typedef unsigned v4u __attribute__((ext_vector_type(4)));
typedef unsigned v2u __attribute__((ext_vector_type(2)));
typedef float f32x4 __attribute__((ext_vector_type(4)));
typedef float f32x2 __attribute__((ext_vector_type(2)));
typedef short bf16x8 __attribute__((ext_vector_type(8)));
typedef short v4i16_t __attribute__((ext_vector_type(4)));
constexpr int NWAVES = 8, NTHR = 512;
constexpr int DM = 2048, NB = 16, SEQ = 2048, DSEQ = 64, PASTL = 2048;
constexpr int MP = NB * SEQ, MS = NB * DSEQ, M = MP + MS;
constexpr int ABW = 4608, CINW = 1344, CINP = 1536, CQR = 768, CKVR = 512, DFF = 8192, PLED = 256;
constexpr int SKV = PASTL + DSEQ;
constexpr int MKV = MP + NB * SKV;
constexpr int NPOS = PASTL + DSEQ;
constexpr float ALPHA = 1.41421356237309505f;
constexpr float LOG2E = 1.44269504088896341f;
constexpr size_t O_PAK = (size_t)M * DM;
constexpr size_t O_PAV = O_PAK + (size_t)16 * 128 * 256;
constexpr size_t O_PBK = O_PAV + (size_t)16 * 128 * 256;
constexpr size_t O_PBV = O_PBK + (size_t)16 * 512 * 1024;
constexpr size_t O_PCKV = O_PBV + (size_t)16 * 512 * 1024;
constexpr size_t O_PCKR = O_PCKV + (size_t)MP * 512;
constexpr size_t O_SAK = O_PCKR + (size_t)MP * 64;
constexpr size_t O_SAV = O_SAK + (size_t)16 * 128 * 256;
constexpr size_t O_SBK = O_SAV + (size_t)16 * 128 * 256;
constexpr size_t O_SBV = O_SBK + (size_t)16 * 512 * 1024;
constexpr size_t O_SCKV = O_SBV + (size_t)16 * 512 * 1024;
constexpr size_t O_SCKR = O_SCKV + (size_t)MS * 512;
constexpr size_t O_END = O_SCKR + (size_t)MS * 64;
static_assert(O_END == 124321792ull, "output size");
constexpr size_t MiB = 1u << 20;
constexpr size_t WS_ROPE128 = 1 * MiB, WS_ROPE64 = 2 * MiB + 512 * 1024;
constexpr size_t WS_W = 4 * MiB;
constexpr size_t W_IN = WS_W, W_QB = WS_W + 6 * MiB, W_KVB = WS_W + 10 * MiB + 512 * 1024, W_OUT = WS_W + 18 * MiB, W_UP = WS_W + 26 * MiB, W_DOWN = WS_W + 58 * MiB, W_GATE = WS_W + 90 * MiB, W_PLE = WS_W + 98 * MiB;
constexpr size_t WS_PB = 104 * MiB;
constexpr size_t AR = 138 * MiB;
constexpr size_t WS_XB = AR, WS_PLE = AR + 132 * MiB, WS_U = AR + 264 * MiB;
constexpr size_t WS_H = AR + 264 * MiB, WS_KAS = AR + 561 * MiB, WS_VAS = WS_KAS + 1536 * 1024, WS_KBS = AR + 564 * MiB, WS_VBS = AR + 582 * MiB, WS_O0 = AR + 600 * MiB;
constexpr size_t WS_HC = AR + 132 * MiB, WS_CQN = AR + 9 * MiB, WS_CKV = AR + 59 * MiB, WS_KR = AR + 850 * MiB, WS_Q = AR + 132 * MiB, WS_KV = AR + 330 * MiB, WS_O1 = AR;
constexpr size_t WS_TP = AR + 792 * MiB;
constexpr size_t WS_STATS = AR + 860 * MiB;
constexpr size_t WS_COL = AR + 862 * MiB;
constexpr size_t WS_ZERO_BYTES = 3 * MiB;
constexpr size_t WS_NEED = AR + 863 * MiB;
static_assert(WS_NEED <= 1024 * MiB, "ws map");
constexpr int LDS_BYTES = 147456;

typedef __attribute__((address_space(1))) unsigned gu32;
#define XB_TMO      128
#define XB_XCNT(j)  (256  + 64 * (j))
#define XB_XSUB(j)  (1280 + 64 * (j))
#define XB_XGEN(j)  (2304 + 64 * (j))
#define XB_TOP      3328
#define XB_TOPGEN   3392
#define XCD_BAR_WORDS 3456
#define XB_SPIN_CAP (1u << 18)

__device__ __forceinline__ unsigned xb_ld(unsigned* p)              { return __hip_atomic_load(p, __ATOMIC_RELAXED, __HIP_MEMORY_SCOPE_AGENT); }
__device__ __forceinline__ unsigned xb_add(unsigned* p, unsigned v) { return __hip_atomic_fetch_add(p, v, __ATOMIC_RELAXED, __HIP_MEMORY_SCOPE_AGENT); }
__device__ __forceinline__ unsigned xb_xcc_id() { return (unsigned)__builtin_amdgcn_s_getreg((3 << 11) | 20) & 0xFu; }
#define XB_SPIN(cond, bar) do { unsigned _sp = 0; while (cond) { __builtin_amdgcn_s_sleep(1); \
    if ((++_sp & 255u) == 0u) { if (xb_ld(&(bar)[XB_TMO])) break; if (_sp > XB_SPIN_CAP) { atomicAdd(&(bar)[XB_TMO], 1u); break; } } } } while (0)

struct XcdBarrier {
    unsigned* bar; unsigned x;
    volatile LAS unsigned* st;
};

__device__ __forceinline__ XcdBarrier xcd_barrier_post(unsigned* bar, volatile LAS unsigned* st) {
    XcdBarrier b; b.bar = bar; b.x = xb_xcc_id(); b.st = st;
    if (threadIdx.x == 0) (void)xb_add(&bar[XB_XCNT(b.x)], 1u);
    return b;
}
__device__ __forceinline__ void xcd_barrier_complete(unsigned* bar, unsigned x, unsigned& nloc, unsigned& nx) {
    const unsigned G = gridDim.x * gridDim.y * gridDim.z;
    unsigned sum, cnt, mine, sp = 0u;
    for (;;) {
        sum = 0u; cnt = 0u; mine = 0u;
#pragma unroll
        for (unsigned j = 0; j < 16; ++j) { const unsigned c = xb_ld(&bar[XB_XCNT(j)]); sum += c; cnt += (c > 0u) ? 1u : 0u; mine = (j == x) ? c : mine; }
        if (sum == G) break;
        __builtin_amdgcn_s_sleep(1);
        if ((++sp & 255u) == 0u) { if (xb_ld(&bar[XB_TMO])) break; if (sp > XB_SPIN_CAP) { atomicAdd(&bar[XB_TMO], 1u); break; } }
    }
    nloc = mine > 0u ? mine : 1u; nx = cnt > 0u ? cnt : 1u;
}

__device__ __forceinline__ void xcd_barrier(const XcdBarrier& b) {
    asm volatile("s_waitcnt vmcnt(0)" ::: "memory");
    __syncthreads();
    if (threadIdx.x == 0) {
        unsigned* bar = b.bar;
        __builtin_amdgcn_s_waitcnt(0);
        unsigned nloc = b.st[0], nx = b.st[1];
        if (nloc == 0u) { xcd_barrier_complete(bar, b.x, nloc, nx); b.st[0] = nloc; b.st[1] = nx; }
        const unsigned old = xb_add(&bar[XB_XSUB(b.x)], 1u);
        const unsigned gen = old / nloc;
        if (old + 1u == (gen + 1u) * nloc) {
            __builtin_amdgcn_fence(__ATOMIC_RELEASE, "agent");
            asm volatile("s_waitcnt vmcnt(0)" ::: "memory");
            const unsigned og = xb_add(&bar[XB_TOP], 1u);
            const unsigned tg = og / nx;
            if (og + 1u == (tg + 1u) * nx) xb_add(&bar[XB_TOPGEN], 1u);
            else XB_SPIN(xb_ld(&bar[XB_TOPGEN]) == tg, bar);
            __builtin_amdgcn_fence(__ATOMIC_ACQUIRE, "agent");
            xb_add(&bar[XB_XGEN(b.x)], 1u);
            asm volatile("s_waitcnt vmcnt(0)" ::: "memory");
        } else {
            XB_SPIN(xb_ld(&bar[XB_XGEN(b.x)]) == gen, bar);
            __builtin_amdgcn_fence(__ATOMIC_ACQUIRE, "agent");
            asm volatile("s_waitcnt vmcnt(0)" ::: "memory");
        }
    }
    __syncthreads();
}

struct Args { const float* in[29]; float* out; unsigned char* ws; };
typedef const __attribute__((address_space(4))) Args* KA;
__device__ __forceinline__ KA kargs() { KA p = (KA)__builtin_amdgcn_kernarg_segment_ptr(); asm volatile("" : "+s"(p)); return p; }
struct Ids { int tid, lane, wid, gw, ngw; size_t gt, ngt; };
__device__ __forceinline__ Ids ids() { int t = threadIdx.x; asm volatile("" : "+v"(t)); Ids r; r.tid = t; r.lane = t & 63; r.wid = __builtin_amdgcn_readfirstlane(t >> 6);
    r.gw = (int)blockIdx.x * NWAVES + r.wid; r.ngw = (int)gridDim.x * NWAVES; r.gt = (size_t)blockIdx.x * NTHR + t; r.ngt = (size_t)gridDim.x * NTHR; return r; }

__device__ __forceinline__ unsigned f2bf(float f) { unsigned u = __builtin_bit_cast(unsigned, f); return (u + 0x7fffu + ((u >> 16) & 1u)) >> 16; }
typedef float f32x2_t __attribute__((ext_vector_type(2))); typedef __bf16 bf16x2_t __attribute__((ext_vector_type(2)));
__device__ __forceinline__ unsigned pk2(float lo, float hi) { f32x2_t v = {lo, hi}; bf16x2_t b = __builtin_convertvector(v, bf16x2_t); return __builtin_bit_cast(unsigned, b); }
__device__ __forceinline__ float bflo(unsigned w) { return __uint_as_float(w << 16); }
__device__ __forceinline__ float bfhi(unsigned w) { return __uint_as_float(w & 0xffff0000u); }
#define LDS_WAIT() asm volatile("s_waitcnt lgkmcnt(0)" ::: "memory")
__device__ __forceinline__ float wave_sum(float v) {
#pragma unroll
    for (int o = 1; o < 64; o <<= 1) v += __shfl_xor(v, o);
    return v;
}
__device__ __forceinline__ void transpose_item(const float* W, int K, int N, bf16* WT, const float* gs, const float* bs, float* colc, float* cold, LAS float* scr, int item, int lane) {
    const int nblk = N / 32, kb = item / nblk, nb = item % nblk, k0 = 64 * kb, n0 = 32 * nb;
    { f32x4 wv[8];
#pragma unroll
      for (int i = 0; i < 8; ++i) wv[i] = *(const f32x4*)(W + (size_t)(k0 + 8 * i + (lane >> 3)) * N + n0 + 4 * (lane & 7));
#pragma unroll
      for (int i = 0; i < 8; ++i) { LAS float* d = scr + (8 * i + (lane >> 3)) * 33 + 4 * (lane & 7); d[0] = wv[i][0]; d[1] = wv[i][1]; d[2] = wv[i][2]; d[3] = wv[i][3]; } }
    LDS_WAIT(); asm volatile("" ::: "memory");
    const int c = lane & 7;
    float gk[8], bk[8];
    if (gs) {
#pragma unroll
        for (int e = 0; e < 8; ++e) { gk[e] = gs[k0 + 8 * c + e]; bk[e] = bs[k0 + 8 * c + e]; } }
#pragma unroll
    for (int j = 0; j < 4; ++j) { const int n = (lane >> 3) + 8 * j; const LAS float* sp = scr + (8 * c) * 33 + n;
        float w[8];
#pragma unroll
        for (int e = 0; e < 8; ++e) w[e] = sp[e * 33];
        v4u o;
        if (gs) { float dsum = 0.f;
#pragma unroll
            for (int e = 0; e < 8; ++e) { dsum += bk[e] * w[e]; w[e] *= gk[e]; }
            o.x = pk2(w[0], w[1]); o.y = pk2(w[2], w[3]); o.z = pk2(w[4], w[5]); o.w = pk2(w[6], w[7]);
            float csum = (bflo(o.x) + bfhi(o.x)) + (bflo(o.y) + bfhi(o.y)) + (bflo(o.z) + bfhi(o.z)) + (bflo(o.w) + bfhi(o.w));
            csum += __shfl_xor(csum, 1); csum += __shfl_xor(csum, 2); csum += __shfl_xor(csum, 4);
            dsum += __shfl_xor(dsum, 1); dsum += __shfl_xor(dsum, 2); dsum += __shfl_xor(dsum, 4);
            if (c == 0) { __hip_atomic_fetch_add(colc + n0 + n, csum, __ATOMIC_RELAXED, __HIP_MEMORY_SCOPE_AGENT); __hip_atomic_fetch_add(cold + n0 + n, dsum, __ATOMIC_RELAXED, __HIP_MEMORY_SCOPE_AGENT); }
        } else { o.x = pk2(w[0], w[1]); o.y = pk2(w[2], w[3]); o.z = pk2(w[4], w[5]); o.w = pk2(w[6], w[7]); }
        *(v4u*)(WT + (size_t)(n0 + n) * K + k0 + 8 * c) = o; }
    LDS_WAIT(); asm volatile("" ::: "memory");
}
struct WJob { const float* W; int K, N; bf16* WT; const float* gs; const float* bs; float* colc; float* cold; };
template <int NJ> __device__ __forceinline__ void transpose_jobs(const WJob (&jobs)[NJ], LAS float* scr, int gw, int ngw, int lane) {
    int base = 0;
#pragma unroll
    for (int j = 0; j < NJ; ++j) {
        const int items = (jobs[j].K / 64) * (jobs[j].N / 32);
        int it = gw - (base % ngw); if (it < 0) it += ngw;
        for (; it < items; it += ngw) transpose_item(jobs[j].W, jobs[j].K, jobs[j].N, jobs[j].WT, jobs[j].gs, jobs[j].bs, jobs[j].colc, jobs[j].cold, scr, it, lane);
        base += items;
    }
}
__device__ __forceinline__ void cvt_flat(const float* src, bf16* dst, size_t n8, size_t gt, size_t ngt) {
    for (size_t i0 = gt; i0 < n8; i0 += 4 * ngt) {
        f32x4 a[4], b[4];
#pragma unroll
        for (int u = 0; u < 4; ++u) { const size_t i = i0 + u * ngt; if (i < n8) { a[u] = *(const f32x4*)(src + 8 * i); b[u] = *(const f32x4*)(src + 8 * i + 4); } }
#pragma unroll
        for (int u = 0; u < 4; ++u) { const size_t i = i0 + u * ngt; if (i < n8) { v4u o; o.x = pk2(a[u][0], a[u][1]); o.y = pk2(a[u][2], a[u][3]); o.z = pk2(b[u][0], b[u][1]); o.w = pk2(b[u][2], b[u][3]); *(v4u*)(dst + 8 * i) = o; } }
    }
}
__device__ __forceinline__ void cvt_seg(const float* src, size_t sstride, bf16* dst, size_t dstride, size_t per, size_t gt, size_t ngt) {
    const size_t per8 = per / 8, n = 16 * per8;
    for (size_t i = gt; i < n; i += ngt) { const size_t b = i / per8, r = i % per8; const float* s = src + b * sstride + 8 * r;
        const f32x4 a = *(const f32x4*)s, c = *(const f32x4*)(s + 4);
        v4u o; o.x = pk2(a[0], a[1]); o.y = pk2(a[2], a[3]); o.z = pk2(c[0], c[1]); o.w = pk2(c[2], c[3]); *(v4u*)(dst + b * dstride + 8 * r) = o; }
}
__device__ __forceinline__ void copy_seg(const float* src, size_t sstride, float* dst, size_t dstride, size_t per, size_t gt, size_t ngt) {
    const size_t per4 = per / 4, n = 16 * per4;
    for (size_t i = gt; i < n; i += ngt) { const size_t b = i / per4, r = i % per4; *(f32x4*)(dst + b * dstride + 4 * r) = *(const f32x4*)(src + b * sstride + 4 * r); }
}
constexpr int KSPLIT = 8;
__device__ __forceinline__ void row_mr(const float* stats, int row, float& mean, float& rstd) { const f32x2 st = *(const f32x2*)(stats + 2 * (size_t)row); mean = st[0] * (1.0f / DM); const float var = st[1] * (1.0f / DM) - mean * mean; rstd = 1.0f / sqrtf(fmaxf(var, 0.f) + 1e-5f); }
__device__ __forceinline__ void sample_fix(bool ln_in, const bf16* X, const float* stats_in, const float* g, const float* bta, const float* Tp, bf16* T, float* stats_out, int gw, int ngw, int lane) {
    for (int r = gw; r < MS; r += ngw) { const int m = MP + r;
        float mean = 0.f, rstd = 1.f; if (ln_in) row_mr(stats_in, m, mean, rstd);
        float t[4][8]; float s1 = 0.f, s2 = 0.f;
#pragma unroll
        for (int j = 0; j < 4; ++j) { const int c8 = lane + 64 * j; const v4u w = ((const v4u*)(X + (size_t)m * DM))[c8];
            float x[8] = {bflo(w.x), bfhi(w.x), bflo(w.y), bfhi(w.y), bflo(w.z), bfhi(w.z), bflo(w.w), bfhi(w.w)};
            if (ln_in) { const f32x4 g0 = ((const f32x4*)g)[2 * c8], g1 = ((const f32x4*)g)[2 * c8 + 1], b0 = ((const f32x4*)bta)[2 * c8], b1 = ((const f32x4*)bta)[2 * c8 + 1];
#pragma unroll
                for (int e = 0; e < 4; ++e) { x[e] = (x[e] - mean) * rstd * g0[e] + b0[e]; x[4 + e] = (x[4 + e] - mean) * rstd * g1[e] + b1[e]; } }
            f32x4 a0 = {0.f, 0.f, 0.f, 0.f}, a1 = {0.f, 0.f, 0.f, 0.f};
#pragma unroll
            for (int sp = 0; sp < KSPLIT; ++sp) { const f32x4* p = (const f32x4*)(Tp + ((size_t)sp * MS + r) * DM) + 2 * c8; a0 += p[0]; a1 += p[1]; }
#pragma unroll
            for (int e = 0; e < 4; ++e) { t[j][e] = x[e] * ALPHA + a0[e]; t[j][4 + e] = x[4 + e] * ALPHA + a1[e]; }
#pragma unroll
            for (int e = 0; e < 8; ++e) { s1 += t[j][e]; s2 += t[j][e] * t[j][e]; }
            v4u o; o.x = pk2(t[j][0], t[j][1]); o.y = pk2(t[j][2], t[j][3]); o.z = pk2(t[j][4], t[j][5]); o.w = pk2(t[j][6], t[j][7]); ((v4u*)(T + (size_t)m * DM))[c8] = o; }
        s1 = wave_sum(s1); s2 = wave_sum(s2);
        if (lane == 0) *(f32x2*)(stats_out + 2 * (size_t)m) = (f32x2){s1, s2};
    }
}

__device__ __forceinline__ void l0_post(KA A, int gw, int ngw, int lane, size_t gt, size_t ngt, bool do_rope = true) {
    bf16* H = (bf16*)(A->ws + WS_H); float* out = A->out;
    const f32x4* rope = (const f32x4*)(A->ws + WS_ROPE128);
    bf16* KAS = (bf16*)(A->ws + WS_KAS); bf16* VAS = (bf16*)(A->ws + WS_VAS); bf16* KBS = (bf16*)(A->ws + WS_KBS); bf16* VBS = (bf16*)(A->ws + WS_VBS);
    for (int m = gw; m < M; m += ngw) {
        const bool smp = m >= MP; const int ms = m - MP;
        const int b = smp ? (ms >> 6) : (m >> 11), t = smp ? (ms & 63) : (m & 2047), pos = smp ? PASTL + t : t;
        bf16* hr = H + (size_t)m * ABW;
        const int i2 = (lane & 31) * 2; const f32x4 cs = rope[(size_t)pos * 32 + (lane & 31)];
#pragma unroll
        for (int it = 0; it < 5; ++it) { const int hh = 2 * it + (lane >> 5); unsigned* p1 = (unsigned*)(hr + 128 * hh + i2); unsigned* p2 = (unsigned*)(hr + 128 * hh + 64 + i2);
            const unsigned w1 = *p1, w2 = *p2; const float a0 = bflo(w1), a1 = bfhi(w1), c0 = bflo(w2), c1 = bfhi(w2);
            const float r0 = do_rope ? a0 * cs[0] - c0 * cs[1] : a0, r1 = do_rope ? a1 * cs[2] - c1 * cs[3] : a1, q0 = do_rope ? c0 * cs[0] + a0 * cs[1] : c0, q1 = do_rope ? c1 * cs[2] + a1 * cs[3] : c1;
            *p1 = pk2(r0, r1); *p2 = pk2(q0, q1);
            if (hh >= 8) { const int cc = (hh - 8) * 128 + i2;
                if (smp) { float* d = out + O_SAK + ((size_t)b * 128 + 64 + t) * 256 + cc; *(f32x2*)d = (f32x2){r0, r1}; *(f32x2*)(d + 64) = (f32x2){q0, q1};
                           bf16* e = KAS + ((size_t)b * 192 + 128 + t) * 256 + cc; *(unsigned*)e = pk2(r0, r1); *(unsigned*)(e + 64) = pk2(q0, q1); }
                else if (t >= SEQ - 128) { float* d = out + O_PAK + ((size_t)b * 128 + (t - (SEQ - 128))) * 256 + cc; *(f32x2*)d = (f32x2){r0, r1}; *(f32x2*)(d + 64) = (f32x2){q0, q1}; } } }
        { const v2u w = *(const v2u*)(hr + 1280 + 4 * lane); const f32x4 f = {bflo(w.x), bfhi(w.x), bflo(w.y), bfhi(w.y)};
          if (smp) { *(f32x4*)(out + O_SAV + ((size_t)b * 128 + 64 + t) * 256 + 4 * lane) = f; *(v2u*)(VAS + ((size_t)b * 192 + 128 + t) * 256 + 4 * lane) = w; }
          else if (t >= SEQ - 128) *(f32x4*)(out + O_PAV + ((size_t)b * 128 + (t - (SEQ - 128))) * 256 + 4 * lane) = f; }
        if (smp || t >= SEQ - 512) {
#pragma unroll
            for (int kv = 0; kv < 2; ++kv)
#pragma unroll
                for (int j = 0; j < 2; ++j) { const int c = (lane + 64 * j) * 8; const v4u w = *(const v4u*)(hr + 2560 + 1024 * kv + c);
                    const f32x4 f0 = {bflo(w.x), bfhi(w.x), bflo(w.y), bfhi(w.y)}, f1 = {bflo(w.z), bfhi(w.z), bflo(w.w), bfhi(w.w)};
                    float* d = smp ? out + (kv ? O_SBV : O_SBK) + ((size_t)b * 512 + 448 + t) * 1024 + c : out + (kv ? O_PBV : O_PBK) + ((size_t)b * 512 + (t - (SEQ - 512))) * 1024 + c;
                    *(f32x4*)d = f0; *(f32x4*)(d + 4) = f1;
                    if (smp) *(v4u*)((kv ? VBS : KBS) + ((size_t)b * 576 + 512 + t) * 1024 + c) = w; }
        }
    }
    copy_seg(A->in[2] + 64 * 256, 128 * 256, out + O_SAK, 128 * 256, 64 * 256, gt, ngt);
    copy_seg(A->in[3] + 64 * 256, 128 * 256, out + O_SAV, 128 * 256, 64 * 256, gt, ngt);
    copy_seg(A->in[4] + 64 * 1024, 512 * 1024, out + O_SBK, 512 * 1024, 448 * 1024, gt, ngt);
    copy_seg(A->in[5] + 64 * 1024, 512 * 1024, out + O_SBV, 512 * 1024, 448 * 1024, gt, ngt);
    cvt_seg(A->in[2], 128 * 256, KAS, 192 * 256, 128 * 256, gt, ngt);
    cvt_seg(A->in[3], 128 * 256, VAS, 192 * 256, 128 * 256, gt, ngt);
    cvt_seg(A->in[4], 512 * 1024, KBS, 576 * 1024, 512 * 1024, gt, ngt);
    cvt_seg(A->in[5], 512 * 1024, VBS, 576 * 1024, 512 * 1024, gt, ngt);
}

__device__ __forceinline__ void l1_norm(KA A, int gw, int ngw, int lane, size_t gt, size_t ngt) {
    const bf16* HC = (const bf16*)(A->ws + WS_HC); bf16* CQN = (bf16*)(A->ws + WS_CQN); bf16* CKV = (bf16*)(A->ws + WS_CKV); bf16* KR = (bf16*)(A->ws + WS_KR);
    const f32x2* rope = (const f32x2*)(A->ws + WS_ROPE64);
    const float* gq = A->in[15]; const float* gkv = A->in[17]; float* out = A->out;
    for (int m = gw; m < M; m += ngw) {
        const bool smp = m >= MP; const int ms = m - MP;
        const int b = smp ? (ms >> 6) : 0, t = smp ? (ms & 63) : (m & 2047), pos = smp ? PASTL + t : t;
        const size_t kvrow = smp ? (size_t)MP + (size_t)b * SKV + PASTL + t : (size_t)m;
        const bf16* hr = HC + (size_t)m * CINP;
        f32x4 q[3]; float s = 0.f;
#pragma unroll
        for (int j = 0; j < 3; ++j) { const v2u w = *(const v2u*)(hr + 4 * (lane + 64 * j)); q[j] = (f32x4){bflo(w.x), bfhi(w.x), bflo(w.y), bfhi(w.y)}; s += (q[j][0] * q[j][0] + q[j][1] * q[j][1]) + (q[j][2] * q[j][2] + q[j][3] * q[j][3]); }
        const float rq = 1.f / sqrtf(wave_sum(s) * (1.f / CQR) + 1e-6f);
#pragma unroll
        for (int j = 0; j < 3; ++j) { const f32x4 g = ((const f32x4*)gq)[lane + 64 * j]; const f32x4 o = q[j] * rq * g; v2u w; w.x = pk2(o[0], o[1]); w.y = pk2(o[2], o[3]); *(v2u*)(CQN + (size_t)m * CQR + 4 * (lane + 64 * j)) = w; }
        f32x4 c[2]; float s2 = 0.f;
#pragma unroll
        for (int j = 0; j < 2; ++j) { const v2u w = *(const v2u*)(hr + CQR + 4 * (lane + 64 * j)); c[j] = (f32x4){bflo(w.x), bfhi(w.x), bflo(w.y), bfhi(w.y)}; s2 += (c[j][0] * c[j][0] + c[j][1] * c[j][1]) + (c[j][2] * c[j][2] + c[j][3] * c[j][3]); }
        const float rc = 1.f / sqrtf(wave_sum(s2) * (1.f / CKVR) + 1e-6f);
        float* okv = out + (smp ? O_SCKV + (size_t)ms * 512 : O_PCKV + (size_t)m * 512);
#pragma unroll
        for (int j = 0; j < 2; ++j) { const f32x4 g = ((const f32x4*)gkv)[lane + 64 * j]; const f32x4 o = c[j] * rc * g; *(f32x4*)(okv + 4 * (lane + 64 * j)) = o;
            v2u w; w.x = pk2(o[0], o[1]); w.y = pk2(o[2], o[3]); *(v2u*)(CKV + kvrow * CKVR + 4 * (lane + 64 * j)) = w; }
        { const float v = __uint_as_float((unsigned)hr[CQR + CKVR + lane] << 16); const float o = __shfl_xor(v, 32); const f32x2 cs = rope[(size_t)pos * 32 + (lane & 31)];
          const float r = lane < 32 ? v * cs[0] - o * cs[1] : v * cs[0] + o * cs[1];
          out[(smp ? O_SCKR + (size_t)ms * 64 : O_PCKR + (size_t)m * 64) + lane] = r; KR[kvrow * 64 + lane] = (bf16)f2bf(r); }
    }
    cvt_seg(A->in[6], (size_t)PASTL * 512, CKV + (size_t)MP * 512, (size_t)SKV * 512, (size_t)PASTL * 512, gt, ngt);
    cvt_seg(A->in[7], (size_t)PASTL * 64, KR + (size_t)MP * 64, (size_t)SKV * 64, (size_t)PASTL * 64, gt, ngt);
}

__device__ __forceinline__ void gate_fix(const float* Tp, const float* bg, const bf16* ple, const bf16* T, const float* stats, const float* g, const float* bta, const float* colc, const float* cold, bf16* Xo, float* Yo, size_t gt, size_t ngt) {
    for (size_t i = gt; i < (size_t)MS * DM / 4; i += ngt) { const size_t e = 4 * i, c = e % DM, o = (size_t)MP * DM + e; const int m = MP + (int)(e / DM);
        float mean, rstd; row_mr(stats, m, mean, rstd);
        f32x4 a = {0.f, 0.f, 0.f, 0.f};
#pragma unroll
        for (int sp = 0; sp < KSPLIT; ++sp) a += *(const f32x4*)(Tp + (size_t)sp * MS * DM + e);
        const f32x4 cv = *(const f32x4*)(colc + c), dv = *(const f32x4*)(cold + c) + *(const f32x4*)(bg + c), gv = *(const f32x4*)(g + c), bv = *(const f32x4*)(bta + c);
        const v2u xw = *(const v2u*)(T + o), pw = *(const v2u*)(ple + o);
        const f32x4 x = {bflo(xw.x), bfhi(xw.x), bflo(xw.y), bfhi(xw.y)}, p = {bflo(pw.x), bfhi(pw.x), bflo(pw.y), bfhi(pw.y)}; f32x4 r;
#pragma unroll
        for (int j = 0; j < 4; ++j) { const float v = rstd * (a[j] - mean * cv[j]) + dv[j]; const float xv = (x[j] - mean) * rstd * gv[j] + bv[j]; r[j] = xv + __builtin_amdgcn_rcpf(1.0f + __builtin_amdgcn_exp2f(-LOG2E * v)) * p[j]; }
        if (Xo) { v2u w; w.x = pk2(r[0], r[1]); w.y = pk2(r[2], r[3]); *(v2u*)(Xo + o) = w; } else *(f32x4*)(Yo + o) = r; }
}
__device__ __forceinline__ v4i16_t vtr(const LAS unsigned char* p) { return __builtin_amdgcn_ds_read_tr16_b64_v4i16((LAS v4i16_t*)p); }
__device__ __forceinline__ float xmax_g(float v) {
    auto a = __builtin_amdgcn_permlane16_swap(__float_as_uint(v), __float_as_uint(v), false, false);
    const float m = fmaxf(__uint_as_float(a[0]), __uint_as_float(a[1]));
    auto b = __builtin_amdgcn_permlane32_swap(__float_as_uint(m), __float_as_uint(m), false, false);
    return fmaxf(__uint_as_float(b[0]), __uint_as_float(b[1]));
}
constexpr int ATT_VSTR = 288, ATT_VBYTES = 64 * ATT_VSTR;
template <int DQK, int MODE>
__device__ __forceinline__ void attn_unit(LAS unsigned char* lds, const bf16* qp, int q_stride, const bf16* kp, int k_stride, const bf16* krp, const bf16* vp, int v_stride, bf16* op,
                                          int t0, int t1, int wt0, int wt1, float c1, float sink2, const float* bias_tab, int qpos0, const f32x2* rope_q) {
    constexpr int NDS = DQK / 32, KSTR = DQK * 2 + 32  , KBYTES = 64 * KSTR, NKC = DQK / 64;
    int tid_ = threadIdx.x; asm volatile("" : "+v"(tid_));
    const int tid = tid_, lane = tid & 63, fr = lane & 15, g = lane >> 4;
    LAS float* btab = (LAS float*)(lds + 3 * KBYTES + 3 * ATT_VBYTES);
    const bool wvalid = wt0 < wt1;
    if (MODE == 1) { if (tid < 257) btab[tid] = bias_tab[tid] * LOG2E; }
    bf16x8 qf[2][NDS];
    if (wvalid) {
#pragma unroll
        for (int qs = 0; qs < 2; ++qs) { const bf16* qr = qp + (size_t)(16 * qs + fr) * q_stride + 8 * g;
#pragma unroll
            for (int ds = 0; ds < NDS; ++ds) qf[qs][ds] = *(const bf16x8*)(qr + 32 * ds);
            if (MODE == 2) {
                const f32x2* rp = rope_q + (size_t)(16 * qs + fr) * 32 + 8 * g; bf16x8 a = qf[qs][4], b = qf[qs][5];
#pragma unroll
                for (int j = 0; j < 8; ++j) { const f32x2 cs = rp[j]; const float x1 = __uint_as_float((unsigned)(unsigned short)a[j] << 16), x2 = __uint_as_float((unsigned)(unsigned short)b[j] << 16);
                    a[j] = (short)f2bf(x1 * cs[0] - x2 * cs[1]); b[j] = (short)f2bf(x2 * cs[0] + x1 * cs[1]); }
                qf[qs][4] = a; qf[qs][5] = b; } }
    } else {
#pragma unroll
        for (int qs = 0; qs < 2; ++qs)
#pragma unroll
            for (int ds = 0; ds < NDS; ++ds) qf[qs][ds] = (bf16x8){0, 0, 0, 0, 0, 0, 0, 0};
    }
    f32x4 o[2][8];
#pragma unroll
    for (int qs = 0; qs < 2; ++qs)
#pragma unroll
        for (int dt = 0; dt < 8; ++dt) o[qs][dt] = (f32x4){0.f, 0.f, 0.f, 0.f};
    float mrun[2], lrun[2];
    mrun[0] = mrun[1] = (MODE == 0) ? sink2 : -INFINITY; lrun[0] = lrun[1] = (MODE == 0 && g == 0) ? 1.f : 0.f;
    v4u kregA[NKC], vregA[2];
#define ATT_GLOAD(KR_, VR_, tt) do { const int t_ = (tt) < t1 ? (tt) : t1 - 1; \
        _Pragma("unroll") for (int i = 0; i < 2; ++i) { const int id = tid + 512 * i, row = id >> 4, ch = id & 15; KR_[i] = *(const v4u*)(kp + (size_t)(64 * t_ + row) * k_stride + 8 * ch); VR_[i] = *(const v4u*)(vp + (size_t)(64 * t_ + row) * v_stride + 8 * ch); } \
        if (MODE == 2) { const int row = tid >> 3, ch = tid & 7; KR_[NKC - 1] = *(const v4u*)(krp + (size_t)(64 * t_ + row) * 64 + 8 * ch); } } while (0)
#define ATT_LSTORE(KR_, VR_, slot_) do { \
        _Pragma("unroll") for (int i = 0; i < 2; ++i) { const int id = tid + 512 * i, row = id >> 4, ch = id & 15; *(LAS v4u*)(lds + (slot_) * KBYTES + row * KSTR + 16 * ch) = KR_[i]; *(LAS v4u*)(lds + 3 * KBYTES + (slot_) * ATT_VBYTES + row * ATT_VSTR + 16 * ch) = VR_[i]; } \
        if (MODE == 2) { const int row = tid >> 3, ch = tid & 7; *(LAS v4u*)(lds + (slot_) * KBYTES + row * KSTR + 256 + 16 * ch) = KR_[NKC - 1]; } } while (0)
    ATT_GLOAD(kregA, vregA, t0);
    ATT_LSTORE(kregA, vregA, t0 % 3);
    ATT_GLOAD(kregA, vregA, t0 + 1);
    __syncthreads();
    f32x4 s[2][4];
    auto qk = [&](int t, int slot_) __attribute__((always_inline)) {
        if (wvalid && t >= wt0 && t < wt1) {
            const LAS unsigned char* kb = lds + slot_ * KBYTES;
#pragma unroll
            for (int kt = 0; kt < 4; ++kt) { s[0][kt] = (f32x4){0.f, 0.f, 0.f, 0.f}; s[1][kt] = (f32x4){0.f, 0.f, 0.f, 0.f}; }
            { bf16x8 kf[2][4];
              const LAS unsigned char* kbase = kb + fr * KSTR + g * 16;
#pragma unroll
              for (int kt = 0; kt < 4; ++kt) kf[0][kt] = *(const LAS bf16x8*)(kbase + 16 * kt * KSTR);
#pragma unroll
              for (int ds = 0; ds < NDS; ++ds) {
                  if (ds + 1 < NDS) {
#pragma unroll
                      for (int kt = 0; kt < 4; ++kt) kf[(ds + 1) & 1][kt] = *(const LAS bf16x8*)(kbase + 16 * kt * KSTR + (ds + 1) * 64); }
                  __builtin_amdgcn_sched_barrier(0);
#pragma unroll
                  for (int kt = 0; kt < 4; ++kt) { s[0][kt] = __builtin_amdgcn_mfma_f32_16x16x32_bf16(kf[ds & 1][kt], qf[0][ds], s[0][kt], 0, 0, 0);
                                                   s[1][kt] = __builtin_amdgcn_mfma_f32_16x16x32_bf16(kf[ds & 1][kt], qf[1][ds], s[1][kt], 0, 0, 0); }
                  __builtin_amdgcn_sched_barrier(0); } }
        }
    };
    auto smpv = [&](int t, int vslot) __attribute__((always_inline)) {
        if (wvalid && t >= wt0 && t < wt1) {
            const LAS unsigned char* vb = lds + 3 * KBYTES + vslot * ATT_VBYTES;
            bf16x8 pf[2][2];
            const bool bconst = (MODE == 1) && (qpos0 - (64 * t + 63) >= 128);
            const float bc = (MODE == 1) ? btab[256] : 0.f;
#pragma unroll
            for (int qs = 0; qs < 2; ++qs) {
                float mx;
                if (MODE == 1) {
                    mx = mrun[qs];
#pragma unroll
                    for (int kt = 0; kt < 4; ++kt)
#pragma unroll
                        for (int i = 0; i < 4; ++i) { float bb = bc;
                            if (!bconst) { int d = (qpos0 + 16 * qs + fr) - (64 * t + 16 * kt + 4 * g + i); d = d < -128 ? -128 : (d > 128 ? 128 : d); bb = btab[d + 128]; }
                            const float sc = __builtin_fmaf(s[qs][kt][i], c1, bb); s[qs][kt][i] = sc; mx = fmaxf(mx, sc); }
                } else {
                    float mr = s[qs][0][0];
#pragma unroll
                    for (int kt = 0; kt < 4; ++kt)
#pragma unroll
                        for (int i = 0; i < 4; ++i) mr = fmaxf(mr, s[qs][kt][i]);
                    mx = fmaxf(mrun[qs], mr * c1);
                }
                mx = xmax_g(mx);
                const float alpha = __builtin_amdgcn_exp2f(mrun[qs] - mx); mrun[qs] = mx;
                float rs = 0.f;
#pragma unroll
                for (int kt = 0; kt < 4; ++kt)
#pragma unroll
                    for (int i = 0; i < 4; ++i) { const float p = (MODE == 1) ? __builtin_amdgcn_exp2f(s[qs][kt][i] - mx) : __builtin_amdgcn_exp2f(__builtin_fmaf(s[qs][kt][i], c1, -mx)); rs += p; s[qs][kt][i] = p; }
                lrun[qs] = lrun[qs] * alpha + rs;
                if (__builtin_amdgcn_ballot_w64(alpha != 1.0f) != 0ull) {
#pragma unroll
                    for (int dt = 0; dt < 8; ++dt) o[qs][dt] = o[qs][dt] * alpha; }
#pragma unroll
                for (int sI = 0; sI < 2; ++sI) { v4u w; w.x = pk2(s[qs][2 * sI][0], s[qs][2 * sI][1]); w.y = pk2(s[qs][2 * sI][2], s[qs][2 * sI][3]); w.z = pk2(s[qs][2 * sI + 1][0], s[qs][2 * sI + 1][1]); w.w = pk2(s[qs][2 * sI + 1][2], s[qs][2 * sI + 1][3]);
                    pf[qs][sI] = __builtin_bit_cast(bf16x8, w); }
            }
            const LAS unsigned char* vbase = vb + (4 * g + (fr >> 2)) * ATT_VSTR + (fr & 3) * 8;
            { v4i16_t lo[2][4], hi[2][4];
#pragma unroll
              for (int d = 0; d < 4; ++d) { lo[0][d] = vtr(vbase + d * 32); hi[0][d] = vtr(vbase + 16 * ATT_VSTR + d * 32); }
#pragma unroll
              for (int st = 0; st < 4; ++st) { const int sI = st >> 1;
                  if (st + 1 < 4) { const int s2 = (st + 1) >> 1, d0 = 4 * ((st + 1) & 1);
#pragma unroll
                      for (int d = 0; d < 4; ++d) { lo[(st + 1) & 1][d] = vtr(vbase + (32 * s2) * ATT_VSTR + (d0 + d) * 32); hi[(st + 1) & 1][d] = vtr(vbase + (32 * s2 + 16) * ATT_VSTR + (d0 + d) * 32); } }
                  __builtin_amdgcn_sched_barrier(0);
#pragma unroll
                  for (int d = 0; d < 4; ++d) { const int dt = 4 * (st & 1) + d; const v4i16_t l_ = lo[st & 1][d], h_ = hi[st & 1][d];
                      const bf16x8 vf = {l_[0], l_[1], l_[2], l_[3], h_[0], h_[1], h_[2], h_[3]};
                      o[0][dt] = __builtin_amdgcn_mfma_f32_16x16x32_bf16(vf, pf[0][sI], o[0][dt], 0, 0, 0);
                      o[1][dt] = __builtin_amdgcn_mfma_f32_16x16x32_bf16(vf, pf[1][sI], o[1][dt], 0, 0, 0); }
                  __builtin_amdgcn_sched_barrier(0); } }
        }
    };
    const bool grpB = __builtin_amdgcn_readfirstlane(tid >> 6) >= 4;
    if (grpB) __syncthreads();
    int slot = t0 % 3;
    for (int t = t0; t < t1; ++t) {
        const int nslot = slot == 2 ? 0 : slot + 1;
        qk(t, slot);
        ATT_LSTORE(kregA, vregA, nslot);
        ATT_GLOAD(kregA, vregA, t + 2);
        __syncthreads();
        smpv(t, slot);
        __syncthreads();
        slot = nslot;
    }
    if (!grpB) __syncthreads();
#undef ATT_GLOAD
#undef ATT_LSTORE
    if (wvalid) {
#pragma unroll
        for (int qs = 0; qs < 2; ++qs) { float l = lrun[qs]; l += __shfl_xor(l, 16); l += __shfl_xor(l, 32); const float inv = 1.f / l;
            bf16* orow = op + (size_t)(16 * qs + fr) * DM + 4 * g;
#pragma unroll
            for (int dt = 0; dt < 8; ++dt) { const f32x4 v = o[qs][dt] * inv; v2u w; w.x = pk2(v[0], v[1]); w.y = pk2(v[2], v[3]); *(v2u*)(orow + 16 * dt) = w; } }
    }
}
__device__ __forceinline__ void attn_l0(KA A, LAS unsigned char* lds, int wid) {
    const bf16* H = (const bf16*)(A->ws + WS_H); bf16* O = (bf16*)(A->ws + WS_O0);
    const bf16* KAS = (const bf16*)(A->ws + WS_KAS); const bf16* VAS = (const bf16*)(A->ws + WS_VAS); const bf16* KBS = (const bf16*)(A->ws + WS_KBS); const bf16* VBS = (const bf16*)(A->ws + WS_VBS);
    const float c1 = 0.08838834764831845f * LOG2E;
    const int wq = wid >> 1, wh = wid & 1;
    for (int u = blockIdx.x; u < 1152; u += gridDim.x) {
        const bf16 *qp, *kp, *vp; bf16* op; int ks, t0, t1, w0, w1, qpos0, head;
        if (u < 1024) {
            const int b = u >> 6, c0 = (u & 7) * 4, c = c0 + wq; head = (u >> 3) & 7;
            const size_t row = (size_t)b * SEQ + 64 * c + 32 * wh; const bf16* hb = H + (size_t)b * SEQ * ABW;
            qp = H + row * ABW + 1536 + 128 * head; kp = hb + 2560 + 128 * head; vp = hb + 3584 + 128 * head; ks = ABW; op = O + row * DM + 1024 + 128 * head;
            t0 = c0 >= 8 ? c0 - 8 : 0; t1 = c0 + 4; w0 = c >= 8 ? c - 8 : 0; w1 = c + 1; qpos0 = 64 * c + 32 * wh;
        } else {
            const int v = u - 1024, b = v >> 3; head = v & 7;
            const size_t row = (size_t)MP + b * 64 + 32 * wh;
            qp = H + row * ABW + 1536 + 128 * head; kp = KBS + (size_t)b * 576 * 1024 + 128 * head; vp = VBS + (size_t)b * 576 * 1024 + 128 * head; ks = 1024; op = O + row * DM + 1024 + 128 * head;
            t0 = 0; t1 = 9; w0 = 0; w1 = wid < 2 ? 9 : 0; qpos0 = 512 + 32 * wh;
        }
        attn_unit<128, 1>(lds, qp, ABW, kp, ks, nullptr, vp, ks, op, t0, t1, w0, w1, c1, 0.f, A->in[12] + 257 * head, qpos0, nullptr);
    }
    for (int u = blockIdx.x; u < 1056; u += gridDim.x) {
        const bf16 *qp, *kp, *vp; bf16* op; int ks, t0, t1, head, pos0;
        if (u < 1024) {
            const int b = u >> 6, kvh = (u >> 5) & 1, c = u & 31; head = 4 * kvh + wq;
            const size_t row = (size_t)b * SEQ + 64 * c + 32 * wh; const bf16* hb = H + (size_t)b * SEQ * ABW;
            qp = H + row * ABW + 128 * head; kp = hb + 1024 + 128 * kvh; vp = hb + 1280 + 128 * kvh; ks = ABW; op = O + row * DM + 128 * head;
            t0 = c >= 2 ? c - 2 : 0; t1 = c + 1; pos0 = 64 * c + 32 * wh;
        } else {
            const int v = u - 1024, b = v >> 1, kvh = v & 1; head = 4 * kvh + wq;
            const size_t row = (size_t)MP + b * 64 + 32 * wh;
            qp = H + row * ABW + 128 * head; kp = KAS + (size_t)b * 192 * 256 + 128 * kvh; vp = VAS + (size_t)b * 192 * 256 + 128 * kvh; ks = 256; op = O + row * DM + 128 * head;
            t0 = 0; t1 = 3; pos0 = PASTL + 32 * wh;
        }
        attn_unit<128, 0>(lds, qp, ABW, kp, ks, nullptr, vp, ks, op, t0, t1, t0, t1, c1, A->in[11][head] * LOG2E, nullptr, 0, nullptr);
    }
}
__device__ __forceinline__ void attn_l1(KA A, LAS unsigned char* lds, int wid) {
    const bf16* Q = (const bf16*)(A->ws + WS_Q); const bf16* KV = (const bf16*)(A->ws + WS_KV); const bf16* KR = (const bf16*)(A->ws + WS_KR); bf16* O = (bf16*)(A->ws + WS_O1);
    const f32x2* rope = (const f32x2*)(A->ws + WS_ROPE64);
    const float c1 = 0.07216878364870322f * LOG2E;
    const bool team = gridDim.x == 256;
    for (int u = blockIdx.x; u < 2304; u += gridDim.x) {
        size_t row, kv0; int head, t1, w1, pos0;
        if (u < 2048) {
            int gq, bh;
            if (team) { const int c = blockIdx.x, x = c & 7, j = c >> 3, r = u >> 8; bh = x * 32 + (j >> 3) * 8 + r; gq = ((j & 7) + r) & 7; }
            else { gq = 7 - (u >> 8); bh = u & 255; }
            const int b = bh >> 4; head = bh & 15;
            row = (size_t)b * SEQ + 256 * gq + 32 * wid; kv0 = (size_t)b * SEQ; t1 = 4 * gq + 4; w1 = 4 * gq + (wid >> 1) + 1; pos0 = 256 * gq + 32 * wid;
        } else {
            const int bh = u - 2048, b = bh >> 4; head = bh & 15;
            row = (size_t)MP + b * 64 + 32 * (wid & 1); kv0 = (size_t)MP + (size_t)b * SKV; t1 = 33; w1 = wid < 2 ? 33 : 0; pos0 = PASTL + 32 * (wid & 1);
        }
        attn_unit<192, 2>(lds, Q + row * 3072 + 192 * head, 3072, KV + kv0 * 4096 + 256 * head, 4096, KR + kv0 * 64, KV + kv0 * 4096 + 256 * head + 128, 4096, O + row * DM + 128 * head,
                          0, t1, 0, w1, c1, 0.f, nullptr, 0, rope + (size_t)pos0 * 32);
    }
}
template <class Epi> __device__ __forceinline__ void run_gemm(LAS unsigned char* lds, const bf16* Am, const bf16* Bt, int Mm, int Nn, int Kk, const Epi& E) {
    pg8::Gemm g{Am, Bt, Mm, Nn, Kk}; pg8::StaticOrder S; S.init(Mm, Nn, Kk, (int)gridDim.x, (int)blockIdx.x);
    pg8::gemm_phase<Epi, pg8::StaticOrder, true, true>(lds, g, S, E);
}
template <class Epi> __device__ __forceinline__ void run_gemm_split(LAS unsigned char* lds, const bf16* Am, const bf16* Bt, int Nn, int Kk, const Epi& E) {
    pg8::Gemm g{Am, Bt, M, Nn, Kk}; pg8::SplitOrder S; S.init(MP, MS, Nn, Kk, KSPLIT, (int)gridDim.x, (int)blockIdx.x);
    pg8::gemm_phase<Epi, pg8::SplitOrder, true, true>(lds, g, S, E);
}
#define GSYNC() xcd_barrier(xbar)
template <int L> __device__ __forceinline__ void layer_tail(const XcdBarrier& xbar, LAS unsigned char* lds, size_t o_off  , bool xa_first) {
#define TAIL_PTRS() KA A = kargs(); unsigned char* ws = A->ws; bf16* YR1_ = (bf16*)A->out; bf16* YR2_ = YR1_ + (size_t)M * DM; bf16* XA = xa_first ? YR1_ : YR2_; bf16* XB_ = xa_first ? YR2_ : YR1_; \
    bf16* PLEB = (bf16*)(ws + WS_PLE); bf16* U = (bf16*)(ws + WS_U); float* Tp = (float*)(ws + WS_TP); bf16* T2 = L == 0 ? XA : (bf16*)(ws + WS_XB); \
    float* st1 = (float*)(ws + WS_STATS) + (size_t)(2 * L) * M * 2; float* st2 = st1 + (size_t)M * 2; float* colb = (float*)(ws + WS_COL) + (size_t)L * 20480; \
    const float* g1 = A->in[20] + L * DM; const float* b1 = A->in[21] + L * DM; const float* g2 = A->in[22] + L * DM; const float* b2 = A->in[23] + L * DM; \
    (void)PLEB; (void)U; (void)Tp; (void)T2; (void)XB_; (void)st1; (void)st2; (void)colb; (void)g1; (void)b1; (void)g2; (void)b2
    { TAIL_PTRS();
      run_gemm(lds, (const bf16*)(ws + o_off), (const bf16*)(ws + W_OUT), M, DM, DM, pg8::EpiResid<false>{XA, XB_, DM, ALPHA, Tp, DM / 64, MP, MS, nullptr, nullptr, nullptr, st1});
      { const int G = (int)gridDim.x, nx = (M / 256 * (DM / 256)) % G, c = (int)blockIdx.x;
        pg8::Gemm g{(const bf16*)(ws + WS_PB) + (size_t)L * M * PLED, (const bf16*)(ws + W_PLE), M, DM, PLED}; pg8::StaticOrder S;
        if (nx > 0 && nx < G) { S.init(M, DM, PLED, G - nx, c - nx); if (c >= nx) pg8::gemm_phase<pg8::EpiBf16<0>, pg8::StaticOrder, true, true>(lds, g, S, pg8::EpiBf16<0>{PLEB, DM}); }
        else { S.init(M, DM, PLED, G, c); pg8::gemm_phase<pg8::EpiBf16<0>, pg8::StaticOrder, true, true>(lds, g, S, pg8::EpiBf16<0>{PLEB, DM}); } } }
    GSYNC();
    { TAIL_PTRS(); run_gemm(lds, XB_, (const bf16*)(ws + W_UP), M, DFF, DM, pg8::EpiUpLn{U, DFF, st1, colb, colb + 8192}); }
    GSYNC();
    { TAIL_PTRS(); run_gemm_split(lds, U, (const bf16*)(ws + W_DOWN), DM, DFF, pg8::EpiResid<true>{XB_, T2, DM, ALPHA, Tp, DFF / 64, MP, MS, st1, g1, b1, st2}); }
    GSYNC();
    { TAIL_PTRS(); const Ids I = ids(); sample_fix(true, XB_, st1, g1, b1, Tp, T2, st2, I.gw, I.ngw, I.lane); }
    GSYNC();
    { TAIL_PTRS(); run_gemm_split(lds, T2, (const bf16*)(ws + W_GATE), DM, DM, pg8::EpiGate{A->in[27] + L * DM, PLEB, T2, L == 0 ? XB_ : (bf16*)nullptr, A->out, DM, Tp, DM / 64, MP, MS, st2, g2, b2, colb + 16384, colb + 18432}); }
    GSYNC();
    { TAIL_PTRS(); const Ids I = ids(); gate_fix(Tp, A->in[27] + L * DM, PLEB, T2, st2, g2, b2, colb + 16384, colb + 18432, L == 0 ? XB_ : (bf16*)nullptr, A->out, I.gt, I.ngt); }
#undef TAIL_PTRS
}
__global__ void __launch_bounds__(NTHR, 2) mega_fwd(Args A_) {
    extern __shared__ __attribute__((aligned(16))) unsigned char lds_raw[];
    LAS unsigned char* lds = (LAS unsigned char*)lds_raw;
    volatile LAS unsigned* bst = (volatile LAS unsigned*)(lds + LDS_BYTES - 16);
    if (threadIdx.x < 2) bst[threadIdx.x] = 0u;
    __syncthreads();
    const XcdBarrier xbar = xcd_barrier_post((unsigned*)(A_.ws + WS_COL + 512 * 1024), bst);

#ifdef PROBE_PRO
    for (int rep = 0; rep < 2; ++rep)
#endif
    { KA A = kargs(); const Ids I = ids(); unsigned char* ws = A->ws; const size_t gt = I.gt, ngt = I.ngt; bf16* YR1 = (bf16*)A->out; bf16* Pb = (bf16*)(ws + WS_PB);
      LAS float* scr = (LAS float*)(lds + I.wid * 16384);
#ifndef NO_ROPE
        for (size_t i = gt; i < (size_t)NPOS * 96; i += ngt) { const int pos = (int)(i / 96), k = (int)(i % 96); const bool big = k < 64; const int f = big ? k : k - 64;
            const float inv = exp2f(-(float)f * (big ? (2.0f / 128.0f) : (2.0f / 64.0f)) * 13.287712379549449f);
            const float ang = (float)pos * inv; const double a = (double)ang;
            f32x2 cs = {(float)cos(a), (float)sin(a)};
            if (big) ((f32x2*)(ws + WS_ROPE128))[(size_t)pos * 64 + f] = cs; else ((f32x2*)(ws + WS_ROPE64))[(size_t)pos * 32 + f] = cs; }
#endif
        float* colb = (float*)(ws + WS_COL);
        const WJob jobs[6] = { {A->in[10], DM, ABW, (bf16*)(ws + W_IN), nullptr, nullptr, nullptr, nullptr}, {A->in[13], DM, DM, (bf16*)(ws + W_OUT), nullptr, nullptr, nullptr, nullptr},
                               {A->in[24], DM, DFF, (bf16*)(ws + W_UP), A->in[20], A->in[21], colb, colb + 8192},
                               {A->in[25], DFF, DM, (bf16*)(ws + W_DOWN), nullptr, nullptr, nullptr, nullptr}, {A->in[26], DM, DM, (bf16*)(ws + W_GATE), A->in[22], A->in[23], colb + 16384, colb + 18432},
                               {A->in[28], PLED, DM, (bf16*)(ws + W_PLE), nullptr, nullptr, nullptr, nullptr} };
        transpose_jobs<6>(jobs, scr, I.gw, I.ngw, I.lane);
        cvt_flat(A->in[0], YR1, (size_t)MP * DM / 8, gt, ngt); cvt_flat(A->in[1], YR1 + (size_t)MP * DM, (size_t)MS * DM / 8, gt, ngt);
#pragma unroll
        for (int L = 0; L < 2; ++L) { cvt_flat(A->in[8] + (size_t)L * MP * PLED, Pb + (size_t)L * M * PLED, (size_t)MP * PLED / 8, gt, ngt);
            cvt_flat(A->in[9] + (size_t)L * MS * PLED, Pb + (size_t)L * M * PLED + (size_t)MP * PLED, (size_t)MS * PLED / 8, gt, ngt); }
    }
    cg::this_grid().sync();

    { KA A = kargs(); unsigned char* ws = A->ws; run_gemm(lds, (const bf16*)A->out, (const bf16*)(ws + W_IN), M, ABW, DM, pg8::EpiBf16<0>{(bf16*)(ws + WS_H), ABW}); }
#ifdef PROBE_G1
    __syncthreads(); { KA A = kargs(); unsigned char* ws = A->ws; run_gemm(lds, (const bf16*)A->out, (const bf16*)(ws + W_IN), M, ABW, DM, pg8::EpiBf16<0>{(bf16*)(ws + WS_H), ABW}); }
#endif
    GSYNC();
#ifndef NO_POST
    { const Ids I = ids(); l0_post(kargs(), I.gw, I.ngw, I.lane, I.gt, I.ngt); }
#ifdef PROBE_POST
    __syncthreads(); { const Ids I = ids(); l0_post(kargs(), I.gw, I.ngw, I.lane, I.gt, I.ngt, false); }
#endif
#endif
    GSYNC();
#ifndef NO_ATT0
    { const Ids I = ids(); attn_l0(kargs(), lds, I.wid); }
#endif
#ifdef PROBE_ATT
    __syncthreads(); { const Ids I = ids(); attn_l0(kargs(), lds, I.wid); }
#endif
    GSYNC();
    layer_tail<0>(xbar, lds, WS_O0, true);
#ifdef PROBE_MISC
    for (int rep = 0; rep < 2; ++rep)
#endif
    { KA A = kargs(); const Ids I = ids(); unsigned char* ws = A->ws; LAS float* scr = (LAS float*)(lds + I.wid * 16384);
      float* colb = (float*)(ws + WS_COL) + 20480;
      const WJob jobs[8] = { {A->in[14], DM, CINW, (bf16*)(ws + W_IN), nullptr, nullptr, nullptr, nullptr}, {A->in[16], CQR, 3072, (bf16*)(ws + W_QB), nullptr, nullptr, nullptr, nullptr},
                             {A->in[18], CKVR, 4096, (bf16*)(ws + W_KVB), nullptr, nullptr, nullptr, nullptr}, {A->in[19], DM, DM, (bf16*)(ws + W_OUT), nullptr, nullptr, nullptr, nullptr},
                             {A->in[24] + (size_t)DM * DFF, DM, DFF, (bf16*)(ws + W_UP), A->in[20] + DM, A->in[21] + DM, colb, colb + 8192}, {A->in[25] + (size_t)DFF * DM, DFF, DM, (bf16*)(ws + W_DOWN), nullptr, nullptr, nullptr, nullptr},
                             {A->in[26] + (size_t)DM * DM, DM, DM, (bf16*)(ws + W_GATE), A->in[22] + DM, A->in[23] + DM, colb + 16384, colb + 18432}, {A->in[28] + (size_t)PLED * DM, PLED, DM, (bf16*)(ws + W_PLE), nullptr, nullptr, nullptr, nullptr} };
      transpose_jobs<8>(jobs, scr, I.gw, I.ngw, I.lane);
      v4u z = {0u, 0u, 0u, 0u}; v4u* zp = (v4u*)((bf16*)(ws + W_IN) + (size_t)CINW * DM);
      for (size_t i = I.gt; i < (size_t)(CINP - CINW) * DM / 8; i += I.ngt) zp[i] = z; }
    GSYNC();
    { KA A = kargs(); unsigned char* ws = A->ws; run_gemm(lds, (const bf16*)A->out + (size_t)M * DM, (const bf16*)(ws + W_IN), M, CINP, DM, pg8::EpiBf16<0>{(bf16*)(ws + WS_HC), CINP}); }
#ifdef PROBE_G1
    __syncthreads(); { KA A = kargs(); unsigned char* ws = A->ws; run_gemm(lds, (const bf16*)A->out + (size_t)M * DM, (const bf16*)(ws + W_IN), M, CINP, DM, pg8::EpiBf16<0>{(bf16*)(ws + WS_HC), CINP}); }
#endif
    GSYNC();
#ifndef NO_POST
    { const Ids I = ids(); l1_norm(kargs(), I.gw, I.ngw, I.lane, I.gt, I.ngt); }
#ifdef PROBE_MISC
    { const Ids I = ids(); l1_norm(kargs(), I.gw, I.ngw, I.lane, I.gt, I.ngt); }
#endif
#endif
    GSYNC();
    { KA A = kargs(); unsigned char* ws = A->ws;
      run_gemm(lds, (const bf16*)(ws + WS_CQN), (const bf16*)(ws + W_QB), M, 3072, CQR, pg8::EpiBf16<0>{(bf16*)(ws + WS_Q), 3072});
      run_gemm(lds, (const bf16*)(ws + WS_CKV), (const bf16*)(ws + W_KVB), MKV, 4096, CKVR, pg8::EpiBf16<0>{(bf16*)(ws + WS_KV), 4096});
#ifdef PROBE_G1
      __syncthreads(); run_gemm(lds, (const bf16*)(ws + WS_CQN), (const bf16*)(ws + W_QB), M, 3072, CQR, pg8::EpiBf16<0>{(bf16*)(ws + WS_Q), 3072});
      run_gemm(lds, (const bf16*)(ws + WS_CKV), (const bf16*)(ws + W_KVB), MKV, 4096, CKVR, pg8::EpiBf16<0>{(bf16*)(ws + WS_KV), 4096});
#endif
    }
    GSYNC();
#ifndef NO_ATT1
    { const Ids I = ids(); attn_l1(kargs(), lds, I.wid); }
#endif
#ifdef PROBE_ATT
    __syncthreads(); { const Ids I = ids(); attn_l1(kargs(), lds, I.wid); }
#endif
    GSYNC();
    layer_tail<1>(xbar, lds, WS_O1, false);
}

extern "C" void kernel_launch(void* const* d_in, const int* in_sizes, int n_in, void* d_out, int out_size, void* d_ws, size_t ws_size, hipStream_t stream) {
    static int grid = 0;
    if (grid == 0) {
        if (n_in != 29 || (size_t)out_size != O_END || ws_size < WS_NEED) { fprintf(stderr, "kernel_launch: unexpected shapes (n_in %d, out %d, ws %zu)\n", n_in, out_size, ws_size); grid = -1; return; }
        int dev = 0, cus = 0, per_cu = 0;
        hipGetDevice(&dev); hipDeviceGetAttribute(&cus, hipDeviceAttributeMultiprocessorCount, dev);
        if (hipFuncSetAttribute((const void*)mega_fwd, hipFuncAttributeMaxDynamicSharedMemorySize, LDS_BYTES) != hipSuccess) { fprintf(stderr, "kernel_launch: hipFuncSetAttribute failed\n"); grid = -1; return; }
        if (hipOccupancyMaxActiveBlocksPerMultiprocessor(&per_cu, (const void*)mega_fwd, NTHR, LDS_BYTES) != hipSuccess || per_cu < 1) { fprintf(stderr, "kernel_launch: occupancy query says %d\n", per_cu); per_cu = 1; }
        (void)hipGetLastError();
        grid = cus * 1;
    }
    if (grid < 0) return;
    if (hipMemsetAsync((char*)d_ws + WS_STATS, 0, WS_ZERO_BYTES, stream) != hipSuccess) { fprintf(stderr, "kernel_launch: hipMemsetAsync (stats) failed\n"); return; }
    Args a{};
    for (int i = 0; i < 29; ++i) a.in[i] = (const float*)d_in[i];
    a.out = (float*)d_out; a.ws = (unsigned char*)d_ws;
    void* args[] = {&a};
    hipError_t e = hipLaunchCooperativeKernel((const void*)mega_fwd, dim3(grid), dim3(NTHR), args, LDS_BYTES, stream);
    if (e != hipSuccess) fprintf(stderr, "cooperative launch failed: %s (grid %d)\n", hipGetErrorString(e), grid);
}
```

```cpp
#include <hip/hip_runtime.h>
#include <hip/hip_cooperative_groups.h>
#include <cstdio>
#include <cstdint>
namespace cg = cooperative_groups;
namespace pg8 {
#define PG8_LAS __attribute__((address_space(3)))
typedef unsigned short bf16_t;
typedef short bf16x8 __attribute__((ext_vector_type(8)));
typedef float f32x4 __attribute__((ext_vector_type(4)));
typedef unsigned u32x4 __attribute__((ext_vector_type(4)));
constexpr int BM = 256, BK = 64, HALF = 128, HTB = HALF * BK * 2  , STAGE_BYTES = 8 * HTB, NXCD = 8, WGM = 8;

__host__ __device__ __forceinline__ int lds_byte(int r, int c) { const int st = (r >> 4) * 2 + (c >> 5), rr = r & 15, cc = c & 31, ob = rr * 64 + cc * 2; return st * 1024 + (ob ^ (((ob >> 9) & 1) << 5)); }
__host__ __device__ __forceinline__ void stage_rc(int b, int& R, int& C) { const int st = b / 1024, sb = b % 1024, swz = sb ^ (((sb >> 9) & 1) << 5); R = (st >> 1) * 16 + swz / 64; C = (st & 1) * 32 + (swz % 64) / 2; }
__host__ __device__ __forceinline__ int perm32(int rho) { const int n = rho >> 4, i = rho & 15; return 8 * (i >> 2) + 4 * n + (i & 3); }

struct Unit { int pm, pn, kt0, knt; };
struct Gemm { const bf16_t* A; const bf16_t* Bt; int M, N, K; };

struct StaticOrder {
    int nM, nN, nwg, G, c, nt;
    __host__ __device__ void init(int M, int N, int K, int G_, int c_) { nM = M / BM; nN = N / BM; nwg = nM * nN; G = G_; c = c_; nt = K / BK; }
    __host__ __device__ bool next(int i, Unit& u) const {
        const long L = (long)i * G + c; if (L >= nwg) return false;
        int wgid = (int)L; { const int q = nwg / NXCD, r = nwg % NXCD, xcd = wgid % NXCD, off = wgid / NXCD; wgid = (xcd < r ? xcd * (q + 1) : r * (q + 1) + (xcd - r) * q) + off; }
        const int nig = WGM * nN, gid = wgid / nig, fm = gid * WGM, gsz = (nM - fm) < WGM ? (nM - fm) : WGM;
        u.pm = fm + ((wgid % nig) % gsz); u.pn = (wgid % nig) / gsz; u.kt0 = 0; u.knt = nt; return true;
    }
    __device__ __forceinline__ void a_ready(const Unit&) const {}
    __device__ __forceinline__ void done(const Unit&) const {}
};

struct SplitOrder {
    StaticOrder P; int nMp, nMs, S, nreg;
    __host__ __device__ void init(int Mp, int Ms, int N, int K, int S_, int G_, int c_) { P.init(Mp, N, K, G_, c_); nMp = Mp / BM; nMs = Ms / BM; S = S_; nreg = (P.nwg + G_ - 1) / G_; }
    __host__ __device__ bool next(int i, Unit& u) const {
        Unit t; t.pm = 0; t.pn = 0; t.kt0 = 0; t.knt = P.nt;
        const bool reg = (i < nreg) && P.next(i, t);
        const int i2 = i < nreg ? nreg : i;
        const long j = (long)(i2 - nreg) * P.G + P.c; const bool ok2 = j < (long)nMs * P.nN * S;
        const int tix = (int)(j / S), sp = (int)(j % S), kn = P.nt / S;
        u.pm = reg ? t.pm : nMp + tix / P.nN; u.pn = reg ? t.pn : tix % P.nN; u.kt0 = reg ? 0 : sp * kn; u.knt = reg ? P.nt : kn;
        return reg || ok2;
    }
    __device__ __forceinline__ void a_ready(const Unit&) const {}
    __device__ __forceinline__ void done(const Unit&) const {}
};
__device__ __forceinline__ unsigned cvt_pk_bf16(float lo, float hi) { unsigned r; asm volatile("v_cvt_pk_bf16_f32 %0, %1, %2" : "=v"(r) : "v"(lo), "v"(hi)); return r; }
typedef float f32x2 __attribute__((ext_vector_type(2)));
typedef unsigned u32x2 __attribute__((ext_vector_type(2)));
template <int ACT  > struct EpiBf16 {
    static constexpr bool PERM = true, AFTER_DRAIN = false;
    bf16_t* O; int ldc;
    __device__ __forceinline__ void operator()(const f32x4 (&acc)[2][2][4][2], const Unit& u, int wr, int wc, int fr, int fq) const {
        const int row0 = u.pm * BM + wr * 64 + fr, col0 = u.pn * BM + wc * 32 + 8 * fq;
#pragma unroll
        for (int ai = 0; ai < 2; ++ai)
#pragma unroll
            for (int m = 0; m < 4; ++m) { bf16_t* rowp = O + (size_t)(row0 + ai * HALF + m * 16) * ldc + col0;
#pragma unroll
                for (int bj = 0; bj < 2; ++bj) { f32x4 v0 = acc[ai][bj][m][0], v1 = acc[ai][bj][m][1];
                    if (ACT == 2) {
#pragma unroll
                        for (int j = 0; j < 4; ++j) { const float a = fmaxf(v0[j], 0.f), b = fmaxf(v1[j], 0.f); v0[j] = a * a; v1[j] = b * b; } }
                    u32x4 w; w.x = cvt_pk_bf16(v0[0], v0[1]); w.y = cvt_pk_bf16(v0[2], v0[3]); w.z = cvt_pk_bf16(v1[0], v1[1]); w.w = cvt_pk_bf16(v1[2], v1[3]);
                    *(u32x4*)(rowp + bj * HALF) = w; } }
    }
};
__device__ __forceinline__ float bf_lo(unsigned w) { return __uint_as_float(w << 16); }
__device__ __forceinline__ float bf_hi(unsigned w) { return __uint_as_float(w & 0xffff0000u); }
struct EpiBf16P {
    static constexpr bool PERM = true, AFTER_DRAIN = false;
    bf16_t* O; int ldc; float* Tp; int ldp, full_nt, row_base, part_rows;
    __device__ __forceinline__ void operator()(const f32x4 (&acc)[2][2][4][2], const Unit& u, int wr, int wc, int fr, int fq) const {
        const int row0 = u.pm * BM + wr * 64 + fr, col0 = u.pn * BM + wc * 32 + 8 * fq;
        if (u.knt != full_nt) {
            float* tp = Tp + ((size_t)(u.kt0 / u.knt) * part_rows + (row0 - row_base)) * ldp + col0;
#pragma unroll
            for (int ai = 0; ai < 2; ++ai)
#pragma unroll
                for (int m = 0; m < 4; ++m)
#pragma unroll
                    for (int bj = 0; bj < 2; ++bj) { float* p = tp + (size_t)(ai * HALF + m * 16) * ldp + bj * HALF; *(f32x4*)p = acc[ai][bj][m][0]; *(f32x4*)(p + 4) = acc[ai][bj][m][1]; }
            return; }
#pragma unroll
        for (int ai = 0; ai < 2; ++ai)
#pragma unroll
            for (int m = 0; m < 4; ++m) { bf16_t* rowp = O + (size_t)(row0 + ai * HALF + m * 16) * ldc + col0;
#pragma unroll
                for (int bj = 0; bj < 2; ++bj) { const f32x4 v0 = acc[ai][bj][m][0], v1 = acc[ai][bj][m][1];
                    u32x4 w; w.x = cvt_pk_bf16(v0[0], v0[1]); w.y = cvt_pk_bf16(v0[2], v0[3]); w.z = cvt_pk_bf16(v1[0], v1[1]); w.w = cvt_pk_bf16(v1[2], v1[3]);
                    *(u32x4*)(rowp + bj * HALF) = w; } }
    }
};
typedef float f32x2e __attribute__((ext_vector_type(2)));
__device__ __forceinline__ void row_mr(const float* stats, int row, float& mean, float& rstd) { const f32x2e st = *(const f32x2e*)(stats + 2 * (size_t)row); mean = st.x * (1.0f / 2048.0f); const float var = st.y * (1.0f / 2048.0f) - mean * mean; rstd = 1.0f / sqrtf(fmaxf(var, 0.f) + 1e-5f); }
struct EpiUpLn {
    static constexpr bool PERM = true, AFTER_DRAIN = false;
    bf16_t* O; int ldc; const float* stats; const float* colc; const float* cold;
    __device__ __forceinline__ void operator()(const f32x4 (&acc)[2][2][4][2], const Unit& u, int wr, int wc, int fr, int fq) const {
        const int row0 = u.pm * BM + wr * 64 + fr, col0 = u.pn * BM + wc * 32 + 8 * fq;
        f32x4 cv[2][2], dv[2][2];
#pragma unroll
        for (int bj = 0; bj < 2; ++bj)
#pragma unroll
            for (int n = 0; n < 2; ++n) { cv[bj][n] = *(const f32x4*)(colc + col0 + bj * HALF + 4 * n); dv[bj][n] = *(const f32x4*)(cold + col0 + bj * HALF + 4 * n); }
#pragma unroll
        for (int ai = 0; ai < 2; ++ai)
#pragma unroll
            for (int m = 0; m < 4; ++m) { const int row = row0 + ai * HALF + m * 16; float mean, rstd; row_mr(stats, row, mean, rstd);
                bf16_t* rowp = O + (size_t)row * ldc + col0;
#pragma unroll
                for (int bj = 0; bj < 2; ++bj) { float r[8];
#pragma unroll
                    for (int j = 0; j < 8; ++j) { const float v = rstd * (acc[ai][bj][m][j >> 2][j & 3] - mean * cv[bj][j >> 2][j & 3]) + dv[bj][j >> 2][j & 3]; const float a = fmaxf(v, 0.f); r[j] = a * a; }
                    u32x4 w; w.x = cvt_pk_bf16(r[0], r[1]); w.y = cvt_pk_bf16(r[2], r[3]); w.z = cvt_pk_bf16(r[4], r[5]); w.w = cvt_pk_bf16(r[6], r[7]);
                    *(u32x4*)(rowp + bj * HALF) = w; } }
    }
};
template <bool LN_IN> struct EpiResid {
    static constexpr bool PERM = true, AFTER_DRAIN = false;
    const bf16_t* X; bf16_t* T; int ldc; float alpha; float* Tp; int full_nt, row_base, part_rows; const float* stats_in; const float* g; const float* bta; float* stats_out;
    __device__ __forceinline__ void operator()(const f32x4 (&acc)[2][2][4][2], const Unit& u, int wr, int wc, int fr, int fq) const {
        const int row0 = u.pm * BM + wr * 64 + fr, col0 = u.pn * BM + wc * 32 + 8 * fq;
        if (u.knt != full_nt) {
            float* tp = Tp + ((size_t)(u.kt0 / u.knt) * part_rows + (row0 - row_base)) * ldc + col0;
#pragma unroll
            for (int ai = 0; ai < 2; ++ai)
#pragma unroll
                for (int m = 0; m < 4; ++m)
#pragma unroll
                    for (int bj = 0; bj < 2; ++bj) { float* p = tp + (size_t)(ai * HALF + m * 16) * ldc + bj * HALF; *(f32x4*)p = acc[ai][bj][m][0]; *(f32x4*)(p + 4) = acc[ai][bj][m][1]; }
            return; }
        f32x4 gv[2][2], bv[2][2];
        if (LN_IN) {
#pragma unroll
            for (int bj = 0; bj < 2; ++bj)
#pragma unroll
                for (int n = 0; n < 2; ++n) { gv[bj][n] = *(const f32x4*)(g + col0 + bj * HALF + 4 * n); bv[bj][n] = *(const f32x4*)(bta + col0 + bj * HALF + 4 * n); } }
#pragma unroll
        for (int ai = 0; ai < 2; ++ai)
#pragma unroll
            for (int m = 0; m < 4; ++m) { const int row = row0 + ai * HALF + m * 16; const size_t off = (size_t)row * ldc + col0;
                float mean = 0.f, rstd = 1.f; if (LN_IN) row_mr(stats_in, row, mean, rstd);
                u32x4 x[2];
#pragma unroll
                for (int bj = 0; bj < 2; ++bj) x[bj] = *(const u32x4*)(X + off + bj * HALF);
                float s1 = 0.f, s2 = 0.f;
#pragma unroll
                for (int bj = 0; bj < 2; ++bj) { float xs[8] = {bf_lo(x[bj].x), bf_hi(x[bj].x), bf_lo(x[bj].y), bf_hi(x[bj].y), bf_lo(x[bj].z), bf_hi(x[bj].z), bf_lo(x[bj].w), bf_hi(x[bj].w)}; float t[8];
#pragma unroll
                    for (int j = 0; j < 8; ++j) { float xv = xs[j]; if (LN_IN) xv = (xv - mean) * rstd * gv[bj][j >> 2][j & 3] + bv[bj][j >> 2][j & 3];
                        t[j] = xv * alpha + acc[ai][bj][m][j >> 2][j & 3]; s1 += t[j]; s2 += t[j] * t[j]; }
                    u32x4 w; w.x = cvt_pk_bf16(t[0], t[1]); w.y = cvt_pk_bf16(t[2], t[3]); w.z = cvt_pk_bf16(t[4], t[5]); w.w = cvt_pk_bf16(t[6], t[7]);
                    *(u32x4*)(T + off + bj * HALF) = w; }
                s1 += __shfl_xor(s1, 16); s1 += __shfl_xor(s1, 32); s2 += __shfl_xor(s2, 16); s2 += __shfl_xor(s2, 32);
                if (fq == 0) { __hip_atomic_fetch_add(stats_out + 2 * (size_t)row, s1, __ATOMIC_RELAXED, __HIP_MEMORY_SCOPE_AGENT); __hip_atomic_fetch_add(stats_out + 2 * (size_t)row + 1, s2, __ATOMIC_RELAXED, __HIP_MEMORY_SCOPE_AGENT); }
                if (m & 1) asm volatile("" ::: "memory"); }
    }
};
struct EpiGate {
    static constexpr bool PERM = true, AFTER_DRAIN = false;
    const float* bg; const bf16_t* ple; const bf16_t* X; bf16_t* Xo; float* Yo; int ldc; float* Tp; int full_nt, row_base, part_rows; const float* stats; const float* g; const float* bta; const float* colc; const float* cold;
    __device__ __forceinline__ void operator()(const f32x4 (&acc)[2][2][4][2], const Unit& u, int wr, int wc, int fr, int fq) const {
        const int row0 = u.pm * BM + wr * 64 + fr, col0 = u.pn * BM + wc * 32 + 8 * fq;
        if (u.knt != full_nt) {
            float* tp = Tp + ((size_t)(u.kt0 / u.knt) * part_rows + (row0 - row_base)) * ldc + col0;
#pragma unroll
            for (int ai = 0; ai < 2; ++ai)
#pragma unroll
                for (int m = 0; m < 4; ++m)
#pragma unroll
                    for (int bj = 0; bj < 2; ++bj) { float* p = tp + (size_t)(ai * HALF + m * 16) * ldc + bj * HALF; *(f32x4*)p = acc[ai][bj][m][0]; *(f32x4*)(p + 4) = acc[ai][bj][m][1]; }
            return; }
#pragma unroll
        for (int bj = 0; bj < 2; ++bj) {
            f32x4 gv[2], bv[2], cv[2], dv[2];
#pragma unroll
            for (int n = 0; n < 2; ++n) { const int c = col0 + bj * HALF + 4 * n; gv[n] = *(const f32x4*)(g + c); bv[n] = *(const f32x4*)(bta + c); cv[n] = *(const f32x4*)(colc + c); dv[n] = *(const f32x4*)(cold + c) + *(const f32x4*)(bg + c); }
#pragma unroll
            for (int ai = 0; ai < 2; ++ai)
#pragma unroll
                for (int m = 0; m < 4; ++m) { const int row = row0 + ai * HALF + m * 16; const size_t o = (size_t)row * ldc + col0 + bj * HALF;
                    float mean, rstd; row_mr(stats, row, mean, rstd);
                    const u32x4 xw = *(const u32x4*)(X + o), pw = *(const u32x4*)(ple + o);
                    const float xs[8] = {bf_lo(xw.x), bf_hi(xw.x), bf_lo(xw.y), bf_hi(xw.y), bf_lo(xw.z), bf_hi(xw.z), bf_lo(xw.w), bf_hi(xw.w)};
                    const float ps[8] = {bf_lo(pw.x), bf_hi(pw.x), bf_lo(pw.y), bf_hi(pw.y), bf_lo(pw.z), bf_hi(pw.z), bf_lo(pw.w), bf_hi(pw.w)};
                    float r[8];
#pragma unroll
                    for (int j = 0; j < 8; ++j) { const float v = rstd * (acc[ai][bj][m][j >> 2][j & 3] - mean * cv[j >> 2][j & 3]) + dv[j >> 2][j & 3];
                        const float xv = (xs[j] - mean) * rstd * gv[j >> 2][j & 3] + bv[j >> 2][j & 3];
                        const float gt_ = __builtin_amdgcn_rcpf(1.0f + __builtin_amdgcn_exp2f(-1.44269504089f * v)); r[j] = xv + gt_ * ps[j]; }
                    if (Xo) { u32x4 w; w.x = cvt_pk_bf16(r[0], r[1]); w.y = cvt_pk_bf16(r[2], r[3]); w.z = cvt_pk_bf16(r[4], r[5]); w.w = cvt_pk_bf16(r[6], r[7]); *(u32x4*)(Xo + o) = w; }
                    else { *(f32x4*)(Yo + o) = (f32x4){r[0], r[1], r[2], r[3]}; *(f32x4*)(Yo + o + 4) = (f32x4){r[4], r[5], r[6], r[7]}; }
                    if (m & 1) asm volatile("" ::: "memory"); } }
    }
};
template <class Epi, class Sched, bool ALIGN_EPI = false, bool SP2 = false>
__device__ __forceinline__ void gemm_phase(PG8_LAS unsigned char* lds, const Gemm g, const Sched& S, const Epi& E) {
    int tid_ = threadIdx.x; asm volatile("" : "+v"(tid_));
    const int tid = tid_, wid = __builtin_amdgcn_readfirstlane(tid >> 6), lane = tid & 63, wr = wid >> 2, wc = wid & 3, fr = lane & 15, fq = lane >> 4;
    const int K = g.K, nt = K / BK;
    unsigned voffA[2], voffB[2];
#pragma unroll
    for (int i = 0; i < 2; ++i) { int R, C; stage_rc(tid * 16 + i * 8192, R, C); const int Rb = Epi::PERM ? ((R & ~31) + perm32(R & 31)) : R;
        voffA[i] = (unsigned)(R * K + C) * 2u; voffB[i] = (unsigned)(Rb * K + C) * 2u; }
    const size_t kstep = (size_t)(BK * 2);
    const size_t hstep = (size_t)HALF * K * 2;
    const size_t tstep = 2 * hstep;
    const unsigned ldsw = (unsigned)wid * 1024u;
    const int aoff = lds_byte(wr * 64 + fr, fq * 8), boff = lds_byte(wc * 32 + fr, fq * 8);
#define PG8_SA(b, h) (((b) * 2 + (h)) * HTB)
#define PG8_SB(b, h) ((4 + (b) * 2 + (h)) * HTB)
#define PG8_STAGE(bufoff, gbase, voff) do { _Pragma("unroll") for (int _i = 0; _i < 2; ++_i) \
        __builtin_amdgcn_global_load_lds((const unsigned*)((const char*)(gbase) + (voff)[_i]), (PG8_LAS unsigned*)(lds + (bufoff) + ldsw + _i * 8192), 16, 0, 0); } while (0)
#define PG8_LDA(dst, b, h) do { _Pragma("unroll") for (int m = 0; m < 4; ++m) _Pragma("unroll") for (int k = 0; k < 2; ++k) dst[m][k] = *(const PG8_LAS bf16x8*)(lds + PG8_SA(b, h) + aoff + m * 2048 + k * 1024); } while (0)
#define PG8_LDB(dst, b, h) do { _Pragma("unroll") for (int n = 0; n < 2; ++n) _Pragma("unroll") for (int k = 0; k < 2; ++k) dst[n][k] = *(const PG8_LAS bf16x8*)(lds + PG8_SB(b, h) + boff + n * 2048 + k * 1024); } while (0)
#define PG8_MMA(ai, bj, At, Bt) do { __builtin_amdgcn_s_setprio(1); _Pragma("unroll") for (int m = 0; m < 4; ++m) _Pragma("unroll") for (int n = 0; n < 2; ++n) _Pragma("unroll") for (int k = 0; k < 2; ++k) \
        acc[ai][bj][m][n] = __builtin_amdgcn_mfma_f32_16x16x32_bf16(Bt[n][k], At[m][k], acc[ai][bj][m][n], 0, 0, 0); __builtin_amdgcn_s_setprio(0); } while (0)
#define PG8_WAIT_V(n) asm volatile("s_waitcnt vmcnt(" #n ")" ::: "memory")
#define PG8_WAIT_L(n) asm volatile("s_waitcnt lgkmcnt(" #n ")" ::: "memory")
#define PG8_BAR __builtin_amdgcn_s_barrier()
#define PG8_SCHED __builtin_amdgcn_sched_barrier(0)
    Unit cur, nxt; int ui = 0;
    if (!S.next(0, cur)) return;
    f32x4 acc[2][2][4][2];
#pragma unroll
    for (int a = 0; a < 2; ++a)
#pragma unroll
        for (int b = 0; b < 2; ++b)
#pragma unroll
            for (int m = 0; m < 4; ++m)
#pragma unroll
                for (int n = 0; n < 2; ++n) acc[a][b][m][n] = (f32x4){0.f, 0.f, 0.f, 0.f};
    bf16x8 At[4][2], B0[2][2], B1[2][2];
    const char* cA = (const char*)g.A + (size_t)cur.pm * tstep + (size_t)cur.kt0 * kstep; const char* cB = (const char*)g.Bt + (size_t)cur.pn * tstep + (size_t)cur.kt0 * kstep;
    S.a_ready(cur);
    if constexpr (SP2) {
        PG8_STAGE(PG8_SB(0, 0), cB, voffB); PG8_STAGE(PG8_SB(0, 1), cB + hstep, voffB); PG8_STAGE(PG8_SA(0, 0), cA, voffA); PG8_STAGE(PG8_SA(0, 1), cA + hstep, voffA);
        if (wr == 1) PG8_BAR;
        PG8_WAIT_V(2); PG8_BAR;
        PG8_STAGE(PG8_SB(1, 0), cB + kstep, voffB); PG8_STAGE(PG8_SA(1, 0), cA + kstep, voffA); PG8_STAGE(PG8_SB(1, 1), cB + hstep + kstep, voffB);
        PG8_WAIT_V(6); PG8_BAR;
    } else {
        PG8_STAGE(PG8_SB(0, 0), cB, voffB); PG8_STAGE(PG8_SA(0, 0), cA, voffA); PG8_STAGE(PG8_SB(0, 1), cB + hstep, voffB); PG8_STAGE(PG8_SA(0, 1), cA + hstep, voffA);
        if (wr == 1) PG8_BAR;
        PG8_WAIT_V(4); PG8_BAR;
        PG8_STAGE(PG8_SB(1, 0), cB + kstep, voffB); PG8_STAGE(PG8_SA(1, 0), cA + kstep, voffA); PG8_STAGE(PG8_SB(1, 1), cB + hstep + kstep, voffB);
        PG8_WAIT_V(6); PG8_BAR;
    }
    for (;;) {
        const bool has_next = S.next(ui + 1, nxt);
        const char* nA = has_next ? (const char*)g.A + (size_t)nxt.pm * tstep + (size_t)nxt.kt0 * kstep : cA; const char* nB = has_next ? (const char*)g.Bt + (size_t)nxt.pn * tstep + (size_t)nxt.kt0 * kstep : cB;
        const int unt = cur.knt;
        for (int t = 0; t < unt; t += 2) {
            const bool last = (t == unt - 2);
            const char* a1 = cA + (size_t)(t + 1) * kstep;
            const char* a2 = last ? nA : cA + (size_t)(t + 2) * kstep; const char* b2 = last ? nB : cB + (size_t)(t + 2) * kstep;
            const char* a3 = a2 + kstep; const char* b3 = b2 + kstep;
            if (last && has_next) S.a_ready(nxt);
            if constexpr (SP2) {
            PG8_LDB(B0, 0, 0); PG8_LDB(B1, 0, 1); PG8_SCHED; PG8_LDA(At, 0, 0); PG8_STAGE(PG8_SA(1, 1), a1 + hstep, voffA);
            PG8_WAIT_V(8); PG8_WAIT_L(0); PG8_BAR; PG8_MMA(0, 0, At, B0); PG8_MMA(0, 1, At, B1); PG8_BAR; PG8_SCHED;
            PG8_LDA(At, 0, 1); PG8_STAGE(PG8_SB(0, 0), b2, voffB); PG8_STAGE(PG8_SB(0, 1), b2 + hstep, voffB); PG8_STAGE(PG8_SA(0, 0), a2, voffA);
            PG8_WAIT_V(8); PG8_WAIT_L(0); PG8_BAR; PG8_MMA(1, 0, At, B0); PG8_MMA(1, 1, At, B1); PG8_BAR; PG8_SCHED;
            PG8_LDB(B0, 1, 0); PG8_LDB(B1, 1, 1); PG8_SCHED; PG8_LDA(At, 1, 0); PG8_STAGE(PG8_SA(0, 1), a2 + hstep, voffA);
            PG8_WAIT_V(8); PG8_WAIT_L(0); PG8_BAR; PG8_MMA(0, 0, At, B0); PG8_MMA(0, 1, At, B1); PG8_BAR; PG8_SCHED;
            PG8_LDA(At, 1, 1); PG8_STAGE(PG8_SB(1, 0), b3, voffB); PG8_STAGE(PG8_SB(1, 1), b3 + hstep, voffB); PG8_STAGE(PG8_SA(1, 0), a3, voffA);
            PG8_WAIT_V(8); PG8_WAIT_L(0); PG8_BAR; PG8_MMA(1, 0, At, B0); PG8_MMA(1, 1, At, B1); PG8_BAR; PG8_SCHED;
            } else {
            PG8_LDB(B0, 0, 0); PG8_SCHED; PG8_LDA(At, 0, 0); PG8_STAGE(PG8_SA(1, 1), a1 + hstep, voffA);
            PG8_WAIT_L(8); PG8_BAR; PG8_WAIT_L(0); PG8_MMA(0, 0, At, B0); PG8_BAR; PG8_SCHED;
            PG8_LDB(B1, 0, 1); PG8_STAGE(PG8_SB(0, 0), b2, voffB);
            PG8_BAR; PG8_WAIT_L(0); PG8_MMA(0, 1, At, B1); PG8_BAR;
            PG8_LDA(At, 0, 1); PG8_STAGE(PG8_SA(0, 0), a2, voffA);
            PG8_BAR; PG8_WAIT_L(0); PG8_MMA(1, 0, At, B0); PG8_BAR; PG8_SCHED;
            PG8_STAGE(PG8_SB(0, 1), b2 + hstep, voffB);
            PG8_WAIT_V(6); PG8_BAR; PG8_MMA(1, 1, At, B1); PG8_BAR;
            PG8_LDB(B0, 1, 0); PG8_SCHED; PG8_LDA(At, 1, 0); PG8_STAGE(PG8_SA(0, 1), a2 + hstep, voffA);
            PG8_WAIT_L(8); PG8_BAR; PG8_WAIT_L(0); PG8_MMA(0, 0, At, B0); PG8_BAR; PG8_SCHED;
            PG8_LDB(B1, 1, 1); PG8_STAGE(PG8_SB(1, 0), b3, voffB);
            PG8_BAR; PG8_WAIT_L(0); PG8_MMA(0, 1, At, B1); PG8_BAR;
            PG8_LDA(At, 1, 1); PG8_STAGE(PG8_SA(1, 0), a3, voffA);
            PG8_BAR; PG8_WAIT_L(0); PG8_MMA(1, 0, At, B0); PG8_BAR; PG8_SCHED;
            PG8_STAGE(PG8_SB(1, 1), b3 + hstep, voffB);
            PG8_WAIT_V(6); PG8_BAR; PG8_MMA(1, 1, At, B1); PG8_BAR;
            }
        }
        if constexpr (ALIGN_EPI) { if (wr == 0) PG8_BAR; }
        if constexpr (!Epi::AFTER_DRAIN) { E(acc, cur, wr, wc, fr, fq); S.done(cur); }
        if (!has_next) break;
#pragma unroll
        for (int a = 0; a < 2; ++a)
#pragma unroll
            for (int b = 0; b < 2; ++b)
#pragma unroll
                for (int m = 0; m < 4; ++m)
#pragma unroll
                    for (int n = 0; n < 2; ++n) acc[a][b][m][n] = (f32x4){0.f, 0.f, 0.f, 0.f};
        cur = nxt; cA = nA; cB = nB; ++ui;
        if constexpr (ALIGN_EPI) { if (wr == 1) PG8_BAR; }
    }
    PG8_WAIT_V(0);
    if constexpr (!ALIGN_EPI) { if (wr == 0) PG8_BAR; }
    PG8_BAR;
    if constexpr (Epi::AFTER_DRAIN) { E.fused(acc, cur, wr, wc, fr, fq, lds, wid, lane); S.done(cur); }
#undef PG8_SA
#undef PG8_SB
#undef PG8_STAGE
#undef PG8_LDA
#undef PG8_LDB
#undef PG8_MMA
#undef PG8_WAIT_V
#undef PG8_WAIT_L
#undef PG8_BAR
#undef PG8_SCHED
}
}
#define LAS __attribute__((address_space(3)))
typedef unsigned short bf16;
typedef unsigned v4u __attribute__((ext_vector_type(4)));
typedef unsigned v2u __attribute__((ext_vector_type(2)));
typedef float f32x4 __attribute__((ext_vector_type(4)));
typedef float f32x2 __attribute__((ext_vector_type(2)));
typedef short bf16x8 __attribute__((ext_vector_type(8)));
typedef short v4i16_t __attribute__((ext_vector_type(4)));
constexpr int NWAVES = 8, NTHR = 512;
constexpr int DM = 2048, NB = 16, SEQ = 2048, DSEQ = 64, PASTL = 2048;
constexpr int MP = NB * SEQ, MS = NB * DSEQ, M = MP + MS;
constexpr int ABW = 4608, CINW = 1344, CINP = 1536, CQR = 768, CKVR = 512, DFF = 8192, PLED = 256;
constexpr int SKV = PASTL + DSEQ;
constexpr int MKV = MP + NB * SKV;
constexpr int NPOS = PASTL + DSEQ;
constexpr float ALPHA = 1.41421356237309505f;
constexpr float LOG2E = 1.44269504088896341f;
constexpr size_t O_PAK = (size_t)M * DM;
constexpr size_t O_PAV = O_PAK + (size_t)16 * 128 * 256;
constexpr size_t O_PBK = O_PAV + (size_t)16 * 128 * 256;
constexpr size_t O_PBV = O_PBK + (size_t)16 * 512 * 1024;
constexpr size_t O_PCKV = O_PBV + (size_t)16 * 512 * 1024;
constexpr size_t O_PCKR = O_PCKV + (size_t)MP * 512;
constexpr size_t O_SAK = O_PCKR + (size_t)MP * 64;
constexpr size_t O_SAV = O_SAK + (size_t)16 * 128 * 256;
constexpr size_t O_SBK = O_SAV + (size_t)16 * 128 * 256;
constexpr size_t O_SBV = O_SBK + (size_t)16 * 512 * 1024;
constexpr size_t O_SCKV = O_SBV + (size_t)16 * 512 * 1024;
constexpr size_t O_SCKR = O_SCKV + (size_t)MS * 512;
constexpr size_t O_END = O_SCKR + (size_t)MS * 64;
static_assert(O_END == 124321792ull, "output size");
constexpr size_t MiB = 1u << 20;
constexpr size_t WS_ROPE128 = 1 * MiB, WS_ROPE64 = 2 * MiB + 512 * 1024;
constexpr size_t WS_W = 4 * MiB;
constexpr size_t W_IN = WS_W, W_QB = WS_W + 6 * MiB, W_KVB = WS_W + 10 * MiB + 512 * 1024, W_OUT = WS_W + 18 * MiB, W_UP = WS_W + 26 * MiB, W_DOWN = WS_W + 58 * MiB, W_GATE = WS_W + 90 * MiB, W_PLE = WS_W + 98 * MiB;
constexpr size_t WS_PB = 104 * MiB;
constexpr size_t AR = 138 * MiB;
constexpr size_t WS_XB = AR, WS_PLE = AR + 132 * MiB, WS_U = AR + 264 * MiB;
constexpr size_t WS_H = AR + 264 * MiB, WS_KAS = AR + 561 * MiB, WS_VAS = WS_KAS + 1536 * 1024, WS_KBS = AR + 564 * MiB, WS_VBS = AR + 582 * MiB, WS_O0 = AR + 600 * MiB;
constexpr size_t WS_HC = AR + 132 * MiB, WS_CQN = AR + 9 * MiB, WS_CKV = AR + 59 * MiB, WS_KR = AR + 850 * MiB, WS_Q = AR + 132 * MiB, WS_KV = AR + 330 * MiB, WS_O1 = AR;
constexpr size_t WS_TP = AR + 792 * MiB;
constexpr size_t WS_STATS = AR + 860 * MiB;
constexpr size_t WS_COL = AR + 862 * MiB;
constexpr size_t WS_ZERO_BYTES = 3 * MiB;
constexpr size_t WS_NEED = AR + 863 * MiB;
static_assert(WS_NEED <= 1024 * MiB, "ws map");
constexpr int LDS_BYTES = 147456;

typedef __attribute__((address_space(1))) unsigned gu32;
#define XB_TMO      128
#define XB_XCNT(j)  (256  + 64 * (j))
#define XB_XSUB(j)  (1280 + 64 * (j))
#define XB_XGEN(j)  (2304 + 64 * (j))
#define XB_TOP      3328
#define XB_TOPGEN   3392
#define XCD_BAR_WORDS 3456
#define XB_SPIN_CAP (1u << 18)

__device__ __forceinline__ unsigned xb_ld(unsigned* p)              { return __hip_atomic_load(p, __ATOMIC_RELAXED, __HIP_MEMORY_SCOPE_AGENT); }
__device__ __forceinline__ unsigned xb_add(unsigned* p, unsigned v) { return __hip_atomic_fetch_add(p, v, __ATOMIC_RELAXED, __HIP_MEMORY_SCOPE_AGENT); }
__device__ __forceinline__ unsigned xb_xcc_id() { return (unsigned)__builtin_amdgcn_s_getreg((3 << 11) | 20) & 0xFu; }
#define XB_SPIN(cond, bar) do { unsigned _sp = 0; while (cond) { __builtin_amdgcn_s_sleep(1); \
    if ((++_sp & 255u) == 0u) { if (xb_ld(&(bar)[XB_TMO])) break; if (_sp > XB_SPIN_CAP) { atomicAdd(&(bar)[XB_TMO], 1u); break; } } } } while (0)

struct XcdBarrier {
    unsigned* bar; unsigned x;
    volatile LAS unsigned* st;
};

__device__ __forceinline__ XcdBarrier xcd_barrier_post(unsigned* bar, volatile LAS unsigned* st) {
    XcdBarrier b; b.bar = bar; b.x = xb_xcc_id(); b.st = st;
    if (threadIdx.x == 0) (void)xb_add(&bar[XB_XCNT(b.x)], 1u);
    return b;
}
__device__ __forceinline__ void xcd_barrier_complete(unsigned* bar, unsigned x, unsigned& nloc, unsigned& nx) {
    const unsigned G = gridDim.x * gridDim.y * gridDim.z;
    unsigned sum, cnt, mine, sp = 0u;
    for (;;) {
        sum = 0u; cnt = 0u; mine = 0u;
#pragma unroll
        for (unsigned j = 0; j < 16; ++j) { const unsigned c = xb_ld(&bar[XB_XCNT(j)]); sum += c; cnt += (c > 0u) ? 1u : 0u; mine = (j == x) ? c : mine; }
        if (sum == G) break;
        __builtin_amdgcn_s_sleep(1);
        if ((++sp & 255u) == 0u) { if (xb_ld(&bar[XB_TMO])) break; if (sp > XB_SPIN_CAP) { atomicAdd(&bar[XB_TMO], 1u); break; } }
    }
    nloc = mine > 0u ? mine : 1u; nx = cnt > 0u ? cnt : 1u;
}

__device__ __forceinline__ void xcd_barrier(const XcdBarrier& b) {
    asm volatile("s_waitcnt vmcnt(0)" ::: "memory");
    __syncthreads();
    if (threadIdx.x == 0) {
        unsigned* bar = b.bar;
        __builtin_amdgcn_s_waitcnt(0);
        unsigned nloc = b.st[0], nx = b.st[1];
        if (nloc == 0u) { xcd_barrier_complete(bar, b.x, nloc, nx); b.st[0] = nloc; b.st[1] = nx; }
        const unsigned old = xb_add(&bar[XB_XSUB(b.x)], 1u);
        const unsigned gen = old / nloc;
        if (old + 1u == (gen + 1u) * nloc) {
            __builtin_amdgcn_fence(__ATOMIC_RELEASE, "agent");
            asm volatile("s_waitcnt vmcnt(0)" ::: "memory");
            const unsigned og = xb_add(&bar[XB_TOP], 1u);
            const unsigned tg = og / nx;
            if (og + 1u == (tg + 1u) * nx) xb_add(&bar[XB_TOPGEN], 1u);
            else XB_SPIN(xb_ld(&bar[XB_TOPGEN]) == tg, bar);
            __builtin_amdgcn_fence(__ATOMIC_ACQUIRE, "agent");
            xb_add(&bar[XB_XGEN(b.x)], 1u);
            asm volatile("s_waitcnt vmcnt(0)" ::: "memory");
        } else {
            XB_SPIN(xb_ld(&bar[XB_XGEN(b.x)]) == gen, bar);
            __builtin_amdgcn_fence(__ATOMIC_ACQUIRE, "agent");
            asm volatile("s_waitcnt vmcnt(0)" ::: "memory");
        }
    }
    __syncthreads();
}

struct Args { const float* in[29]; float* out; unsigned char* ws; };
typedef const __attribute__((address_space(4))) Args* KA;
__device__ __forceinline__ KA kargs() { KA p = (KA)__builtin_amdgcn_kernarg_segment_ptr(); asm volatile("" : "+s"(p)); return p; }
struct Ids { int tid, lane, wid, gw, ngw; size_t gt, ngt; };
__device__ __forceinline__ Ids ids() { int t = threadIdx.x; asm volatile("" : "+v"(t)); Ids r; r.tid = t; r.lane = t & 63; r.wid = __builtin_amdgcn_readfirstlane(t >> 6);
    r.gw = (int)blockIdx.x * NWAVES + r.wid; r.ngw = (int)gridDim.x * NWAVES; r.gt = (size_t)blockIdx.x * NTHR + t; r.ngt = (size_t)gridDim.x * NTHR; return r; }

__device__ __forceinline__ unsigned f2bf(float f) { unsigned u = __builtin_bit_cast(unsigned, f); return (u + 0x7fffu + ((u >> 16) & 1u)) >> 16; }
typedef float f32x2_t __attribute__((ext_vector_type(2))); typedef __bf16 bf16x2_t __attribute__((ext_vector_type(2)));
__device__ __forceinline__ unsigned pk2(float lo, float hi) { f32x2_t v = {lo, hi}; bf16x2_t b = __builtin_convertvector(v, bf16x2_t); return __builtin_bit_cast(unsigned, b); }
__device__ __forceinline__ float bflo(unsigned w) { return __uint_as_float(w << 16); }
__device__ __forceinline__ float bfhi(unsigned w) { return __uint_as_float(w & 0xffff0000u); }
#define LDS_WAIT() asm volatile("s_waitcnt lgkmcnt(0)" ::: "memory")
__device__ __forceinline__ float wave_sum(float v) {
#pragma unroll
    for (int o = 1; o < 64; o <<= 1) v += __shfl_xor(v, o);
    return v;
}
__device__ __forceinline__ void transpose_item(const float* W, int K, int N, bf16* WT, const float* gs, const float* bs, float* colc, float* cold, LAS float* scr, int item, int lane) {
    const int nblk = N / 32, kb = item / nblk, nb = item % nblk, k0 = 64 * kb, n0 = 32 * nb;
    { f32x4 wv[8];
#pragma unroll
      for (int i = 0; i < 8; ++i) wv[i] = *(const f32x4*)(W + (size_t)(k0 + 8 * i + (lane >> 3)) * N + n0 + 4 * (lane & 7));
#pragma unroll
      for (int i = 0; i < 8; ++i) { LAS float* d = scr + (8 * i + (lane >> 3)) * 33 + 4 * (lane & 7); d[0] = wv[i][0]; d[1] = wv[i][1]; d[2] = wv[i][2]; d[3] = wv[i][3]; } }
    LDS_WAIT(); asm volatile("" ::: "memory");
    const int c = lane & 7;
    float gk[8], bk[8];
    if (gs) {
#pragma unroll
        for (int e = 0; e < 8; ++e) { gk[e] = gs[k0 + 8 * c + e]; bk[e] = bs[k0 + 8 * c + e]; } }
#pragma unroll
    for (int j = 0; j < 4; ++j) { const int n = (lane >> 3) + 8 * j; const LAS float* sp = scr + (8 * c) * 33 + n;
        float w[8];
#pragma unroll
        for (int e = 0; e < 8; ++e) w[e] = sp[e * 33];
        v4u o;
        if (gs) { float dsum = 0.f;
#pragma unroll
            for (int e = 0; e < 8; ++e) { dsum += bk[e] * w[e]; w[e] *= gk[e]; }
            o.x = pk2(w[0], w[1]); o.y = pk2(w[2], w[3]); o.z = pk2(w[4], w[5]); o.w = pk2(w[6], w[7]);
            float csum = (bflo(o.x) + bfhi(o.x)) + (bflo(o.y) + bfhi(o.y)) + (bflo(o.z) + bfhi(o.z)) + (bflo(o.w) + bfhi(o.w));
            csum += __shfl_xor(csum, 1); csum += __shfl_xor(csum, 2); csum += __shfl_xor(csum, 4);
            dsum += __shfl_xor(dsum, 1); dsum += __shfl_xor(dsum, 2); dsum += __shfl_xor(dsum, 4);
            if (c == 0) { __hip_atomic_fetch_add(colc + n0 + n, csum, __ATOMIC_RELAXED, __HIP_MEMORY_SCOPE_AGENT); __hip_atomic_fetch_add(cold + n0 + n, dsum, __ATOMIC_RELAXED, __HIP_MEMORY_SCOPE_AGENT); }
        } else { o.x = pk2(w[0], w[1]); o.y = pk2(w[2], w[3]); o.z = pk2(w[4], w[5]); o.w = pk2(w[6], w[7]); }
        *(v4u*)(WT + (size_t)(n0 + n) * K + k0 + 8 * c) = o; }
    LDS_WAIT(); asm volatile("" ::: "memory");
}
struct WJob { const float* W; int K, N; bf16* WT; const float* gs; const float* bs; float* colc; float* cold; };
template <int NJ> __device__ __forceinline__ void transpose_jobs(const WJob (&jobs)[NJ], LAS float* scr, int gw, int ngw, int lane) {
    int base = 0;
#pragma unroll
    for (int j = 0; j < NJ; ++j) {
        const int items = (jobs[j].K / 64) * (jobs[j].N / 32);
        int it = gw - (base % ngw); if (it < 0) it += ngw;
        for (; it < items; it += ngw) transpose_item(jobs[j].W, jobs[j].K, jobs[j].N, jobs[j].WT, jobs[j].gs, jobs[j].bs, jobs[j].colc, jobs[j].cold, scr, it, lane);
        base += items;
    }
}
__device__ __forceinline__ void cvt_flat(const float* src, bf16* dst, size_t n8, size_t gt, size_t ngt) {
    for (size_t i = gt; i < n8; i += ngt) { const f32x4 a = *(const f32x4*)(src + 8 * i), b = *(const f32x4*)(src + 8 * i + 4);
        v4u o; o.x = pk2(a[0], a[1]); o.y = pk2(a[2], a[3]); o.z = pk2(b[0], b[1]); o.w = pk2(b[2], b[3]); *(v4u*)(dst + 8 * i) = o; }
}
__device__ __forceinline__ void cvt_seg(const float* src, size_t sstride, bf16* dst, size_t dstride, size_t per, size_t gt, size_t ngt) {
    const size_t per8 = per / 8, n = 16 * per8;
    for (size_t i = gt; i < n; i += ngt) { const size_t b = i / per8, r = i % per8; const float* s = src + b * sstride + 8 * r;
        const f32x4 a = *(const f32x4*)s, c = *(const f32x4*)(s + 4);
        v4u o; o.x = pk2(a[0], a[1]); o.y = pk2(a[2], a[3]); o.z = pk2(c[0], c[1]); o.w = pk2(c[2], c[3]); *(v4u*)(dst + b * dstride + 8 * r) = o; }
}
__device__ __forceinline__ void copy_seg(const float* src, size_t sstride, float* dst, size_t dstride, size_t per, size_t gt, size_t ngt) {
    const size_t per4 = per / 4, n = 16 * per4;
    for (size_t i = gt; i < n; i += ngt) { const size_t b = i / per4, r = i % per4; *(f32x4*)(dst + b * dstride + 4 * r) = *(const f32x4*)(src + b * sstride + 4 * r); }
}
constexpr int KSPLIT = 8;
__device__ __forceinline__ void row_mr(const float* stats, int row, float& mean, float& rstd) { const f32x2 st = *(const f32x2*)(stats + 2 * (size_t)row); mean = st[0] * (1.0f / DM); const float var = st[1] * (1.0f / DM) - mean * mean; rstd = 1.0f / sqrtf(fmaxf(var, 0.f) + 1e-5f); }
__device__ __forceinline__ void sample_fix(bool ln_in, const bf16* X, const float* stats_in, const float* g, const float* bta, const float* Tp, bf16* T, float* stats_out, int gw, int ngw, int lane) {
    for (int r = gw; r < MS; r += ngw) { const int m = MP + r;
        float mean = 0.f, rstd = 1.f; if (ln_in) row_mr(stats_in, m, mean, rstd);
        float t[4][8]; float s1 = 0.f, s2 = 0.f;
#pragma unroll
        for (int j = 0; j < 4; ++j) { const int c8 = lane + 64 * j; const v4u w = ((const v4u*)(X + (size_t)m * DM))[c8];
            float x[8] = {bflo(w.x), bfhi(w.x), bflo(w.y), bfhi(w.y), bflo(w.z), bfhi(w.z), bflo(w.w), bfhi(w.w)};
            if (ln_in) { const f32x4 g0 = ((const f32x4*)g)[2 * c8], g1 = ((const f32x4*)g)[2 * c8 + 1], b0 = ((const f32x4*)bta)[2 * c8], b1 = ((const f32x4*)bta)[2 * c8 + 1];
#pragma unroll
                for (int e = 0; e < 4; ++e) { x[e] = (x[e] - mean) * rstd * g0[e] + b0[e]; x[4 + e] = (x[4 + e] - mean) * rstd * g1[e] + b1[e]; } }
            f32x4 a0 = {0.f, 0.f, 0.f, 0.f}, a1 = {0.f, 0.f, 0.f, 0.f};
#pragma unroll
            for (int sp = 0; sp < KSPLIT; ++sp) { const f32x4* p = (const f32x4*)(Tp + ((size_t)sp * MS + r) * DM) + 2 * c8; a0 += p[0]; a1 += p[1]; }
#pragma unroll
            for (int e = 0; e < 4; ++e) { t[j][e] = x[e] * ALPHA + a0[e]; t[j][4 + e] = x[4 + e] * ALPHA + a1[e]; }
#pragma unroll
            for (int e = 0; e < 8; ++e) { s1 += t[j][e]; s2 += t[j][e] * t[j][e]; }
            v4u o; o.x = pk2(t[j][0], t[j][1]); o.y = pk2(t[j][2], t[j][3]); o.z = pk2(t[j][4], t[j][5]); o.w = pk2(t[j][6], t[j][7]); ((v4u*)(T + (size_t)m * DM))[c8] = o; }
        s1 = wave_sum(s1); s2 = wave_sum(s2);
        if (lane == 0) *(f32x2*)(stats_out + 2 * (size_t)m) = (f32x2){s1, s2};
    }
}

__device__ __forceinline__ void l0_post(KA A, int gw, int ngw, int lane, size_t gt, size_t ngt, bool do_rope = true) {
    bf16* H = (bf16*)(A->ws + WS_H); float* out = A->out;
    const f32x4* rope = (const f32x4*)(A->ws + WS_ROPE128);
    bf16* KAS = (bf16*)(A->ws + WS_KAS); bf16* VAS = (bf16*)(A->ws + WS_VAS); bf16* KBS = (bf16*)(A->ws + WS_KBS); bf16* VBS = (bf16*)(A->ws + WS_VBS);
    for (int m = gw; m < M; m += ngw) {
        const bool smp = m >= MP; const int ms = m - MP;
        const int b = smp ? (ms >> 6) : (m >> 11), t = smp ? (ms & 63) : (m & 2047), pos = smp ? PASTL + t : t;
        bf16* hr = H + (size_t)m * ABW;
        const int i2 = (lane & 31) * 2; const f32x4 cs = rope[(size_t)pos * 32 + (lane & 31)];
#pragma unroll
        for (int it = 0; it < 5; ++it) { const int hh = 2 * it + (lane >> 5); unsigned* p1 = (unsigned*)(hr + 128 * hh + i2); unsigned* p2 = (unsigned*)(hr + 128 * hh + 64 + i2);
            const unsigned w1 = *p1, w2 = *p2; const float a0 = bflo(w1), a1 = bfhi(w1), c0 = bflo(w2), c1 = bfhi(w2);
            const float r0 = do_rope ? a0 * cs[0] - c0 * cs[1] : a0, r1 = do_rope ? a1 * cs[2] - c1 * cs[3] : a1, q0 = do_rope ? c0 * cs[0] + a0 * cs[1] : c0, q1 = do_rope ? c1 * cs[2] + a1 * cs[3] : c1;
            *p1 = pk2(r0, r1); *p2 = pk2(q0, q1);
            if (hh >= 8) { const int cc = (hh - 8) * 128 + i2;
                if (smp) { float* d = out + O_SAK + ((size_t)b * 128 + 64 + t) * 256 + cc; *(f32x2*)d = (f32x2){r0, r1}; *(f32x2*)(d + 64) = (f32x2){q0, q1};
                           bf16* e = KAS + ((size_t)b * 192 + 128 + t) * 256 + cc; *(unsigned*)e = pk2(r0, r1); *(unsigned*)(e + 64) = pk2(q0, q1); }
                else if (t >= SEQ - 128) { float* d = out + O_PAK + ((size_t)b * 128 + (t - (SEQ - 128))) * 256 + cc; *(f32x2*)d = (f32x2){r0, r1}; *(f32x2*)(d + 64) = (f32x2){q0, q1}; } } }
        { const v2u w = *(const v2u*)(hr + 1280 + 4 * lane); const f32x4 f = {bflo(w.x), bfhi(w.x), bflo(w.y), bfhi(w.y)};
          if (smp) { *(f32x4*)(out + O_SAV + ((size_t)b * 128 + 64 + t) * 256 + 4 * lane) = f; *(v2u*)(VAS + ((size_t)b * 192 + 128 + t) * 256 + 4 * lane) = w; }
          else if (t >= SEQ - 128) *(f32x4*)(out + O_PAV + ((size_t)b * 128 + (t - (SEQ - 128))) * 256 + 4 * lane) = f; }
        if (smp || t >= SEQ - 512) {
#pragma unroll
            for (int kv = 0; kv < 2; ++kv)
#pragma unroll
                for (int j = 0; j < 2; ++j) { const int c = (lane + 64 * j) * 8; const v4u w = *(const v4u*)(hr + 2560 + 1024 * kv + c);
                    const f32x4 f0 = {bflo(w.x), bfhi(w.x), bflo(w.y), bfhi(w.y)}, f1 = {bflo(w.z), bfhi(w.z), bflo(w.w), bfhi(w.w)};
                    float* d = smp ? out + (kv ? O_SBV : O_SBK) + ((size_t)b * 512 + 448 + t) * 1024 + c : out + (kv ? O_PBV : O_PBK) + ((size_t)b * 512 + (t - (SEQ - 512))) * 1024 + c;
                    *(f32x4*)d = f0; *(f32x4*)(d + 4) = f1;
                    if (smp) *(v4u*)((kv ? VBS : KBS) + ((size_t)b * 576 + 512 + t) * 1024 + c) = w; }
        }
    }
    copy_seg(A->in[2] + 64 * 256, 128 * 256, out + O_SAK, 128 * 256, 64 * 256, gt, ngt);
    copy_seg(A->in[3] + 64 * 256, 128 * 256, out + O_SAV, 128 * 256, 64 * 256, gt, ngt);
    copy_seg(A->in[4] + 64 * 1024, 512 * 1024, out + O_SBK, 512 * 1024, 448 * 1024, gt, ngt);
    copy_seg(A->in[5] + 64 * 1024, 512 * 1024, out + O_SBV, 512 * 1024, 448 * 1024, gt, ngt);
    cvt_seg(A->in[2], 128 * 256, KAS, 192 * 256, 128 * 256, gt, ngt);
    cvt_seg(A->in[3], 128 * 256, VAS, 192 * 256, 128 * 256, gt, ngt);
    cvt_seg(A->in[4], 512 * 1024, KBS, 576 * 1024, 512 * 1024, gt, ngt);
    cvt_seg(A->in[5], 512 * 1024, VBS, 576 * 1024, 512 * 1024, gt, ngt);
}

__device__ __forceinline__ void l1_norm(KA A, int gw, int ngw, int lane, size_t gt, size_t ngt) {
    const bf16* HC = (const bf16*)(A->ws + WS_HC); bf16* CQN = (bf16*)(A->ws + WS_CQN); bf16* CKV = (bf16*)(A->ws + WS_CKV); bf16* KR = (bf16*)(A->ws + WS_KR);
    const f32x2* rope = (const f32x2*)(A->ws + WS_ROPE64);
    const float* gq = A->in[15]; const float* gkv = A->in[17]; float* out = A->out;
    for (int m = gw; m < M; m += ngw) {
        const bool smp = m >= MP; const int ms = m - MP;
        const int b = smp ? (ms >> 6) : 0, t = smp ? (ms & 63) : (m & 2047), pos = smp ? PASTL + t : t;
        const size_t kvrow = smp ? (size_t)MP + (size_t)b * SKV + PASTL + t : (size_t)m;
        const bf16* hr = HC + (size_t)m * CINP;
        f32x4 q[3]; float s = 0.f;
#pragma unroll
        for (int j = 0; j < 3; ++j) { const v2u w = *(const v2u*)(hr + 4 * (lane + 64 * j)); q[j] = (f32x4){bflo(w.x), bfhi(w.x), bflo(w.y), bfhi(w.y)}; s += (q[j][0] * q[j][0] + q[j][1] * q[j][1]) + (q[j][2] * q[j][2] + q[j][3] * q[j][3]); }
        const float rq = 1.f / sqrtf(wave_sum(s) * (1.f / CQR) + 1e-6f);
#pragma unroll
        for (int j = 0; j < 3; ++j) { const f32x4 g = ((const f32x4*)gq)[lane + 64 * j]; const f32x4 o = q[j] * rq * g; v2u w; w.x = pk2(o[0], o[1]); w.y = pk2(o[2], o[3]); *(v2u*)(CQN + (size_t)m * CQR + 4 * (lane + 64 * j)) = w; }
        f32x4 c[2]; float s2 = 0.f;
#pragma unroll
        for (int j = 0; j < 2; ++j) { const v2u w = *(const v2u*)(hr + CQR + 4 * (lane + 64 * j)); c[j] = (f32x4){bflo(w.x), bfhi(w.x), bflo(w.y), bfhi(w.y)}; s2 += (c[j][0] * c[j][0] + c[j][1] * c[j][1]) + (c[j][2] * c[j][2] + c[j][3] * c[j][3]); }
        const float rc = 1.f / sqrtf(wave_sum(s2) * (1.f / CKVR) + 1e-6f);
        float* okv = out + (smp ? O_SCKV + (size_t)ms * 512 : O_PCKV + (size_t)m * 512);
#pragma unroll
        for (int j = 0; j < 2; ++j) { const f32x4 g = ((const f32x4*)gkv)[lane + 64 * j]; const f32x4 o = c[j] * rc * g; *(f32x4*)(okv + 4 * (lane + 64 * j)) = o;
            v2u w; w.x = pk2(o[0], o[1]); w.y = pk2(o[2], o[3]); *(v2u*)(CKV + kvrow * CKVR + 4 * (lane + 64 * j)) = w; }
        { const float v = __uint_as_float((unsigned)hr[CQR + CKVR + lane] << 16); const float o = __shfl_xor(v, 32); const f32x2 cs = rope[(size_t)pos * 32 + (lane & 31)];
          const float r = lane < 32 ? v * cs[0] - o * cs[1] : v * cs[0] + o * cs[1];
          out[(smp ? O_SCKR + (size_t)ms * 64 : O_PCKR + (size_t)m * 64) + lane] = r; KR[kvrow * 64 + lane] = (bf16)f2bf(r); }
    }
    cvt_seg(A->in[6], (size_t)PASTL * 512, CKV + (size_t)MP * 512, (size_t)SKV * 512, (size_t)PASTL * 512, gt, ngt);
    cvt_seg(A->in[7], (size_t)PASTL * 64, KR + (size_t)MP * 64, (size_t)SKV * 64, (size_t)PASTL * 64, gt, ngt);
}

__device__ __forceinline__ void gate_fix(const float* Tp, const float* bg, const bf16* ple, const bf16* T, const float* stats, const float* g, const float* bta, const float* colc, const float* cold, bf16* Xo, float* Yo, size_t gt, size_t ngt) {
    for (size_t i = gt; i < (size_t)MS * DM / 4; i += ngt) { const size_t e = 4 * i, c = e % DM, o = (size_t)MP * DM + e; const int m = MP + (int)(e / DM);
        float mean, rstd; row_mr(stats, m, mean, rstd);
        f32x4 a = {0.f, 0.f, 0.f, 0.f};
#pragma unroll
        for (int sp = 0; sp < KSPLIT; ++sp) a += *(const f32x4*)(Tp + (size_t)sp * MS * DM + e);
        const f32x4 cv = *(const f32x4*)(colc + c), dv = *(const f32x4*)(cold + c) + *(const f32x4*)(bg + c), gv = *(const f32x4*)(g + c), bv = *(const f32x4*)(bta + c);
        const v2u xw = *(const v2u*)(T + o), pw = *(const v2u*)(ple + o);
        const f32x4 x = {bflo(xw.x), bfhi(xw.x), bflo(xw.y), bfhi(xw.y)}, p = {bflo(pw.x), bfhi(pw.x), bflo(pw.y), bfhi(pw.y)}; f32x4 r;
#pragma unroll
        for (int j = 0; j < 4; ++j) { const float v = rstd * (a[j] - mean * cv[j]) + dv[j]; const float xv = (x[j] - mean) * rstd * gv[j] + bv[j]; r[j] = xv + __builtin_amdgcn_rcpf(1.0f + __builtin_amdgcn_exp2f(-LOG2E * v)) * p[j]; }
        if (Xo) { v2u w; w.x = pk2(r[0], r[1]); w.y = pk2(r[2], r[3]); *(v2u*)(Xo + o) = w; } else *(f32x4*)(Yo + o) = r; }
}
__device__ __forceinline__ v4i16_t vtr(const LAS unsigned char* p) { return __builtin_amdgcn_ds_read_tr16_b64_v4i16((LAS v4i16_t*)p); }
__device__ __forceinline__ float xmax_g(float v) {
    auto a = __builtin_amdgcn_permlane16_swap(__float_as_uint(v), __float_as_uint(v), false, false);
    const float m = fmaxf(__uint_as_float(a[0]), __uint_as_float(a[1]));
    auto b = __builtin_amdgcn_permlane32_swap(__float_as_uint(m), __float_as_uint(m), false, false);
    return fmaxf(__uint_as_float(b[0]), __uint_as_float(b[1]));
}
constexpr int ATT_VSTR = 288, ATT_VBYTES = 64 * ATT_VSTR;
template <int DQK, int MODE>
__device__ __forceinline__ void attn_unit(LAS unsigned char* lds, const bf16* qp, int q_stride, const bf16* kp, int k_stride, const bf16* krp, const bf16* vp, int v_stride, bf16* op,
                                          int t0, int t1, int wt0, int wt1, float c1, float sink2, const float* bias_tab, int qpos0, const f32x2* rope_q) {
    constexpr int NDS = DQK / 32, KSTR = DQK * 2 + 32  , KBYTES = 64 * KSTR, NKC = DQK / 64;
    int tid_ = threadIdx.x; asm volatile("" : "+v"(tid_));
    const int tid = tid_, lane = tid & 63, fr = lane & 15, g = lane >> 4;
    LAS float* btab = (LAS float*)(lds + 3 * KBYTES + 3 * ATT_VBYTES);
    const bool wvalid = wt0 < wt1;
    if (MODE == 1) { if (tid < 257) btab[tid] = bias_tab[tid] * LOG2E; }
    v4u kregA[NKC], vregA[2];
#define ATT_GLOAD(KR_, VR_, tt) do { const int t_ = (tt) < t1 ? (tt) : t1 - 1; \
        _Pragma("unroll") for (int i = 0; i < 2; ++i) { const int id = tid + 512 * i, row = id >> 4, ch = id & 15; KR_[i] = *(const v4u*)(kp + (size_t)(64 * t_ + row) * k_stride + 8 * ch); VR_[i] = *(const v4u*)(vp + (size_t)(64 * t_ + row) * v_stride + 8 * ch); } \
        if (MODE == 2) { const int row = tid >> 3, ch = tid & 7; KR_[NKC - 1] = *(const v4u*)(krp + (size_t)(64 * t_ + row) * 64 + 8 * ch); } } while (0)
#define ATT_LSTORE(KR_, VR_, slot_) do { \
        _Pragma("unroll") for (int i = 0; i < 2; ++i) { const int id = tid + 512 * i, row = id >> 4, ch = id & 15; *(LAS v4u*)(lds + (slot_) * KBYTES + row * KSTR + 16 * ch) = KR_[i]; *(LAS v4u*)(lds + 3 * KBYTES + (slot_) * ATT_VBYTES + row * ATT_VSTR + 16 * ch) = VR_[i]; } \
        if (MODE == 2) { const int row = tid >> 3, ch = tid & 7; *(LAS v4u*)(lds + (slot_) * KBYTES + row * KSTR + 256 + 16 * ch) = KR_[NKC - 1]; } } while (0)
    ATT_GLOAD(kregA, vregA, t0);
    bf16x8 qf[2][NDS];
    if (wvalid) {
#pragma unroll
        for (int qs = 0; qs < 2; ++qs) { const bf16* qr = qp + (size_t)(16 * qs + fr) * q_stride + 8 * g;
#pragma unroll
            for (int ds = 0; ds < NDS; ++ds) qf[qs][ds] = *(const bf16x8*)(qr + 32 * ds);
            if (MODE == 2) {
                const f32x2* rp = rope_q + (size_t)(16 * qs + fr) * 32 + 8 * g; bf16x8 a = qf[qs][4], b = qf[qs][5];
#pragma unroll
                for (int j = 0; j < 8; ++j) { const f32x2 cs = rp[j]; const float x1 = __uint_as_float((unsigned)(unsigned short)a[j] << 16), x2 = __uint_as_float((unsigned)(unsigned short)b[j] << 16);
                    a[j] = (short)f2bf(x1 * cs[0] - x2 * cs[1]); b[j] = (short)f2bf(x2 * cs[0] + x1 * cs[1]); }
                qf[qs][4] = a; qf[qs][5] = b; } }
    } else {
#pragma unroll
        for (int qs = 0; qs < 2; ++qs)
#pragma unroll
            for (int ds = 0; ds < NDS; ++ds) qf[qs][ds] = (bf16x8){0, 0, 0, 0, 0, 0, 0, 0};
    }
    f32x4 o[2][8];
#pragma unroll
    for (int qs = 0; qs < 2; ++qs)
#pragma unroll
        for (int dt = 0; dt < 8; ++dt) o[qs][dt] = (f32x4){0.f, 0.f, 0.f, 0.f};
    float mrun[2], lrun[2];
    mrun[0] = mrun[1] = (MODE == 0) ? sink2 : -INFINITY; lrun[0] = lrun[1] = (MODE == 0 && g == 0) ? 1.f : 0.f;
    ATT_LSTORE(kregA, vregA, t0 % 3);
    ATT_GLOAD(kregA, vregA, t0 + 1);
    __syncthreads();
    f32x4 s[2][4];
    auto qk = [&](int t, int slot_) __attribute__((always_inline)) {
        if (wvalid && t >= wt0 && t < wt1) {
            const LAS unsigned char* kb = lds + slot_ * KBYTES;
#pragma unroll
            for (int kt = 0; kt < 4; ++kt) { s[0][kt] = (f32x4){0.f, 0.f, 0.f, 0.f}; s[1][kt] = (f32x4){0.f, 0.f, 0.f, 0.f}; }
            { bf16x8 kf[2][4];
              const LAS unsigned char* kbase = kb + fr * KSTR + g * 16;
#pragma unroll
              for (int kt = 0; kt < 4; ++kt) kf[0][kt] = *(const LAS bf16x8*)(kbase + 16 * kt * KSTR);
#pragma unroll
              for (int ds = 0; ds < NDS; ++ds) {
                  if (ds + 1 < NDS) {
#pragma unroll
                      for (int kt = 0; kt < 4; ++kt) kf[(ds + 1) & 1][kt] = *(const LAS bf16x8*)(kbase + 16 * kt * KSTR + (ds + 1) * 64); }
                  __builtin_amdgcn_sched_barrier(0);
#pragma unroll
                  for (int kt = 0; kt < 4; ++kt) { s[0][kt] = __builtin_amdgcn_mfma_f32_16x16x32_bf16(kf[ds & 1][kt], qf[0][ds], s[0][kt], 0, 0, 0);
                                                   s[1][kt] = __builtin_amdgcn_mfma_f32_16x16x32_bf16(kf[ds & 1][kt], qf[1][ds], s[1][kt], 0, 0, 0); }
                  __builtin_amdgcn_sched_barrier(0); } }
        }
    };
    auto smpv = [&](int t, int vslot) __attribute__((always_inline)) {
        if (wvalid && t >= wt0 && t < wt1) {
            const LAS unsigned char* vb = lds + 3 * KBYTES + vslot * ATT_VBYTES;
            bf16x8 pf[2][2];
            const bool bconst = (MODE == 1) && (qpos0 - (64 * t + 63) >= 128);
            const float bc = (MODE == 1) ? btab[256] : 0.f;
#pragma unroll
            for (int qs = 0; qs < 2; ++qs) {
                float mx;
                if (MODE == 1) {
                    mx = mrun[qs];
#pragma unroll
                    for (int kt = 0; kt < 4; ++kt)
#pragma unroll
                        for (int i = 0; i < 4; ++i) { float bb = bc;
                            if (!bconst) { int d = (qpos0 + 16 * qs + fr) - (64 * t + 16 * kt + 4 * g + i); d = d < -128 ? -128 : (d > 128 ? 128 : d); bb = btab[d + 128]; }
                            const float sc = __builtin_fmaf(s[qs][kt][i], c1, bb); s[qs][kt][i] = sc; mx = fmaxf(mx, sc); }
                } else {
                    float mr = s[qs][0][0];
#pragma unroll
                    for (int kt = 0; kt < 4; ++kt)
#pragma unroll
                        for (int i = 0; i < 4; ++i) mr = fmaxf(mr, s[qs][kt][i]);
                    mx = fmaxf(mrun[qs], mr * c1);
                }
                mx = xmax_g(mx);
                const float alpha = __builtin_amdgcn_exp2f(mrun[qs] - mx); mrun[qs] = mx;
                float rs = 0.f;
#pragma unroll
                for (int kt = 0; kt < 4; ++kt)
#pragma unroll
                    for (int i = 0; i < 4; ++i) { const float p = (MODE == 1) ? __builtin_amdgcn_exp2f(s[qs][kt][i] - mx) : __builtin_amdgcn_exp2f(__builtin_fmaf(s[qs][kt][i], c1, -mx)); rs += p; s[qs][kt][i] = p; }
                lrun[qs] = lrun[qs] * alpha + rs;
                if (__builtin_amdgcn_ballot_w64(alpha != 1.0f) != 0ull) {
#pragma unroll
                    for (int dt = 0; dt < 8; ++dt) o[qs][dt] = o[qs][dt] * alpha; }
#pragma unroll
                for (int sI = 0; sI < 2; ++sI) { v4u w; w.x = pk2(s[qs][2 * sI][0], s[qs][2 * sI][1]); w.y = pk2(s[qs][2 * sI][2], s[qs][2 * sI][3]); w.z = pk2(s[qs][2 * sI + 1][0], s[qs][2 * sI + 1][1]); w.w = pk2(s[qs][2 * sI + 1][2], s[qs][2 * sI + 1][3]);
                    pf[qs][sI] = __builtin_bit_cast(bf16x8, w); }
            }
            const LAS unsigned char* vbase = vb + (4 * g + (fr >> 2)) * ATT_VSTR + (fr & 3) * 8;
            { v4i16_t lo[2][4], hi[2][4];
#pragma unroll
              for (int d = 0; d < 4; ++d) { lo[0][d] = vtr(vbase + d * 32); hi[0][d] = vtr(vbase + 16 * ATT_VSTR + d * 32); }
#pragma unroll
              for (int st = 0; st < 4; ++st) { const int sI = st >> 1;
                  if (st + 1 < 4) { const int s2 = (st + 1) >> 1, d0 = 4 * ((st + 1) & 1);
#pragma unroll
                      for (int d = 0; d < 4; ++d) { lo[(st + 1) & 1][d] = vtr(vbase + (32 * s2) * ATT_VSTR + (d0 + d) * 32); hi[(st + 1) & 1][d] = vtr(vbase + (32 * s2 + 16) * ATT_VSTR + (d0 + d) * 32); } }
                  __builtin_amdgcn_sched_barrier(0);
#pragma unroll
                  for (int d = 0; d < 4; ++d) { const int dt = 4 * (st & 1) + d; const v4i16_t l_ = lo[st & 1][d], h_ = hi[st & 1][d];
                      const bf16x8 vf = {l_[0], l_[1], l_[2], l_[3], h_[0], h_[1], h_[2], h_[3]};
                      o[0][dt] = __builtin_amdgcn_mfma_f32_16x16x32_bf16(vf, pf[0][sI], o[0][dt], 0, 0, 0);
                      o[1][dt] = __builtin_amdgcn_mfma_f32_16x16x32_bf16(vf, pf[1][sI], o[1][dt], 0, 0, 0); }
                  __builtin_amdgcn_sched_barrier(0); } }
        }
    };
    const bool grpB = __builtin_amdgcn_readfirstlane(tid >> 6) >= 4;
    if (grpB) __syncthreads();
    int slot = t0 % 3;
    for (int t = t0; t < t1; ++t) {
        const int nslot = slot == 2 ? 0 : slot + 1;
        qk(t, slot);
        ATT_LSTORE(kregA, vregA, nslot);
#ifdef PROBE_ATTLOAD
        ATT_GLOAD(kregA, vregA, t + 1);
#pragma unroll
        for (int i_ = 0; i_ < 2; ++i_) asm volatile("" :: "v"(kregA[i_]), "v"(vregA[i_]));
        if (MODE == 2) asm volatile("" :: "v"(kregA[NKC - 1]));
#endif
        ATT_GLOAD(kregA, vregA, t + 2);
        __syncthreads();
        smpv(t, slot);
        __syncthreads();
        slot = nslot;
    }
    if (!grpB) __syncthreads();
#undef ATT_GLOAD
#undef ATT_LSTORE
    if (wvalid) {
#pragma unroll
        for (int qs = 0; qs < 2; ++qs) { float l = lrun[qs]; l += __shfl_xor(l, 16); l += __shfl_xor(l, 32); const float inv = 1.f / l;
            bf16* orow = op + (size_t)(16 * qs + fr) * DM + 4 * g;
#pragma unroll
            for (int dt = 0; dt < 8; ++dt) { const f32x4 v = o[qs][dt] * inv; v2u w; w.x = pk2(v[0], v[1]); w.y = pk2(v[2], v[3]); *(v2u*)(orow + 16 * dt) = w; } }
    }
}
__device__ __forceinline__ void attn_l0(KA A, LAS unsigned char* lds, int wid) {
    const bf16* H = (const bf16*)(A->ws + WS_H); bf16* O = (bf16*)(A->ws + WS_O0);
    const bf16* KAS = (const bf16*)(A->ws + WS_KAS); const bf16* VAS = (const bf16*)(A->ws + WS_VAS); const bf16* KBS = (const bf16*)(A->ws + WS_KBS); const bf16* VBS = (const bf16*)(A->ws + WS_VBS);
    const float c1 = 0.08838834764831845f * LOG2E;
    const int wq = wid >> 1, wh = wid & 1;
    for (int u = blockIdx.x; u < 1152; u += gridDim.x) {
        const bf16 *qp, *kp, *vp; bf16* op; int ks, t0, t1, w0, w1, qpos0, head;
        if (u < 1024) {
            const int b = u >> 6, c0 = (u & 7) * 4, c = c0 + wq; head = (u >> 3) & 7;
            const size_t row = (size_t)b * SEQ + 64 * c + 32 * wh; const bf16* hb = H + (size_t)b * SEQ * ABW;
            qp = H + row * ABW + 1536 + 128 * head; kp = hb + 2560 + 128 * head; vp = hb + 3584 + 128 * head; ks = ABW; op = O + row * DM + 1024 + 128 * head;
            t0 = c0 >= 8 ? c0 - 8 : 0; t1 = c0 + 4; w0 = c >= 8 ? c - 8 : 0; w1 = c + 1; qpos0 = 64 * c + 32 * wh;
        } else {
            const int v = u - 1024, b = v >> 3; head = v & 7;
            const size_t row = (size_t)MP + b * 64 + 32 * wh;
            qp = H + row * ABW + 1536 + 128 * head; kp = KBS + (size_t)b * 576 * 1024 + 128 * head; vp = VBS + (size_t)b * 576 * 1024 + 128 * head; ks = 1024; op = O + row * DM + 1024 + 128 * head;
            t0 = 0; t1 = 9; w0 = 0; w1 = wid < 2 ? 9 : 0; qpos0 = 512 + 32 * wh;
        }
        attn_unit<128, 1>(lds, qp, ABW, kp, ks, nullptr, vp, ks, op, t0, t1, w0, w1, c1, 0.f, A->in[12] + 257 * head, qpos0, nullptr);
    }
    for (int u = blockIdx.x; u < 1056; u += gridDim.x) {
        const bf16 *qp, *kp, *vp; bf16* op; int ks, t0, t1, head, pos0;
        if (u < 1024) {
            const int b = u >> 6, kvh = (u >> 5) & 1, c = u & 31; head = 4 * kvh + wq;
            const size_t row = (size_t)b * SEQ + 64 * c + 32 * wh; const bf16* hb = H + (size_t)b * SEQ * ABW;
            qp = H + row * ABW + 128 * head; kp = hb + 1024 + 128 * kvh; vp = hb + 1280 + 128 * kvh; ks = ABW; op = O + row * DM + 128 * head;
            t0 = c >= 2 ? c - 2 : 0; t1 = c + 1; pos0 = 64 * c + 32 * wh;
        } else {
            const int v = u - 1024, b = v >> 1, kvh = v & 1; head = 4 * kvh + wq;
            const size_t row = (size_t)MP + b * 64 + 32 * wh;
            qp = H + row * ABW + 128 * head; kp = KAS + (size_t)b * 192 * 256 + 128 * kvh; vp = VAS + (size_t)b * 192 * 256 + 128 * kvh; ks = 256; op = O + row * DM + 128 * head;
            t0 = 0; t1 = 3; pos0 = PASTL + 32 * wh;
        }
        attn_unit<128, 0>(lds, qp, ABW, kp, ks, nullptr, vp, ks, op, t0, t1, t0, t1, c1, A->in[11][head] * LOG2E, nullptr, 0, nullptr);
    }
}
__device__ __forceinline__ void attn_l1(KA A, LAS unsigned char* lds, int wid) {
    const bf16* Q = (const bf16*)(A->ws + WS_Q); const bf16* KV = (const bf16*)(A->ws + WS_KV); const bf16* KR = (const bf16*)(A->ws + WS_KR); bf16* O = (bf16*)(A->ws + WS_O1);
    const f32x2* rope = (const f32x2*)(A->ws + WS_ROPE64);
    const float c1 = 0.07216878364870322f * LOG2E;
    const bool team = gridDim.x == 256;
    for (int u = blockIdx.x; u < 2304; u += gridDim.x) {
        size_t row, kv0; int head, t1, w1, pos0;
        if (u < 2048) {
            int gq, bh;
            if (team) { const int c = blockIdx.x, x = c & 7, j = c >> 3, r = u >> 8; bh = x * 32 + (j >> 3) * 8 + r; gq = ((j & 7) + r) & 7; }
            else { gq = 7 - (u >> 8); bh = u & 255; }
            const int b = bh >> 4; head = bh & 15;
            row = (size_t)b * SEQ + 256 * gq + 32 * wid; kv0 = (size_t)b * SEQ; t1 = 4 * gq + 4; w1 = 4 * gq + (wid >> 1) + 1; pos0 = 256 * gq + 32 * wid;
        } else {
            const int bh = u - 2048, b = bh >> 4; head = bh & 15;
            row = (size_t)MP + b * 64 + 32 * (wid & 1); kv0 = (size_t)MP + (size_t)b * SKV; t1 = 33; w1 = wid < 2 ? 33 : 0; pos0 = PASTL + 32 * (wid & 1);
        }
        attn_unit<192, 2>(lds, Q + row * 3072 + 192 * head, 3072, KV + kv0 * 4096 + 256 * head, 4096, KR + kv0 * 64, KV + kv0 * 4096 + 256 * head + 128, 4096, O + row * DM + 128 * head,
                          0, t1, 0, w1, c1, 0.f, nullptr, 0, rope + (size_t)pos0 * 32);
    }
}
template <class Epi> __device__ __forceinline__ void run_gemm(LAS unsigned char* lds, const bf16* Am, const bf16* Bt, int Mm, int Nn, int Kk, const Epi& E) {
    pg8::Gemm g{Am, Bt, Mm, Nn, Kk}; pg8::StaticOrder S; S.init(Mm, Nn, Kk, (int)gridDim.x, (int)blockIdx.x);
    pg8::gemm_phase<Epi, pg8::StaticOrder, true, true>(lds, g, S, E);
}
template <class Epi> __device__ __forceinline__ void run_gemm_split(LAS unsigned char* lds, const bf16* Am, const bf16* Bt, int Nn, int Kk, const Epi& E) {
    pg8::Gemm g{Am, Bt, M, Nn, Kk}; pg8::SplitOrder S; S.init(MP, MS, Nn, Kk, KSPLIT, (int)gridDim.x, (int)blockIdx.x);
    pg8::gemm_phase<Epi, pg8::SplitOrder, true, true>(lds, g, S, E);
}
#define GSYNC() xcd_barrier(xbar)
template <int L> __device__ __forceinline__ void layer_tail(const XcdBarrier& xbar, LAS unsigned char* lds, size_t o_off  , bool xa_first) {
#define TAIL_PTRS() KA A = kargs(); unsigned char* ws = A->ws; bf16* YR1_ = (bf16*)A->out; bf16* YR2_ = YR1_ + (size_t)M * DM; bf16* XA = xa_first ? YR1_ : YR2_; bf16* XB_ = xa_first ? YR2_ : YR1_; \
    bf16* PLEB = (bf16*)(ws + WS_PLE); bf16* U = (bf16*)(ws + WS_U); float* Tp = (float*)(ws + WS_TP); bf16* T2 = L == 0 ? XA : (bf16*)(ws + WS_XB); \
    float* st1 = (float*)(ws + WS_STATS) + (size_t)(2 * L) * M * 2; float* st2 = st1 + (size_t)M * 2; float* colb = (float*)(ws + WS_COL) + (size_t)L * 20480; \
    const float* g1 = A->in[20] + L * DM; const float* b1 = A->in[21] + L * DM; const float* g2 = A->in[22] + L * DM; const float* b2 = A->in[23] + L * DM; \
    (void)PLEB; (void)U; (void)Tp; (void)T2; (void)XB_; (void)st1; (void)st2; (void)colb; (void)g1; (void)b1; (void)g2; (void)b2
    { TAIL_PTRS();
      run_gemm(lds, (const bf16*)(ws + o_off), (const bf16*)(ws + W_OUT), M, DM, DM, pg8::EpiResid<false>{XA, XB_, DM, ALPHA, Tp, DM / 64, MP, MS, nullptr, nullptr, nullptr, st1});
      { const int G = (int)gridDim.x, nx = (M / 256 * (DM / 256)) % G, c = (int)blockIdx.x;
        pg8::Gemm g{(const bf16*)(ws + WS_PB) + (size_t)L * M * PLED, (const bf16*)(ws + W_PLE), M, DM, PLED}; pg8::StaticOrder S;
        if (nx > 0 && nx < G) { S.init(M, DM, PLED, G - nx, c - nx); if (c >= nx) pg8::gemm_phase<pg8::EpiBf16<0>, pg8::StaticOrder, true, true>(lds, g, S, pg8::EpiBf16<0>{PLEB, DM}); }
        else { S.init(M, DM, PLED, G, c); pg8::gemm_phase<pg8::EpiBf16<0>, pg8::StaticOrder, true, true>(lds, g, S, pg8::EpiBf16<0>{PLEB, DM}); } } }
    GSYNC();
    { TAIL_PTRS(); run_gemm(lds, XB_, (const bf16*)(ws + W_UP), M, DFF, DM, pg8::EpiUpLn{U, DFF, st1, colb, colb + 8192}); }
    GSYNC();
    { TAIL_PTRS(); run_gemm_split(lds, U, (const bf16*)(ws + W_DOWN), DM, DFF, pg8::EpiResid<true>{XB_, T2, DM, ALPHA, Tp, DFF / 64, MP, MS, st1, g1, b1, st2}); }
    GSYNC();
    { TAIL_PTRS(); const Ids I = ids(); sample_fix(true, XB_, st1, g1, b1, Tp, T2, st2, I.gw, I.ngw, I.lane); }
    GSYNC();
    { TAIL_PTRS(); run_gemm_split(lds, T2, (const bf16*)(ws + W_GATE), DM, DM, pg8::EpiGate{A->in[27] + L * DM, PLEB, T2, L == 0 ? XB_ : (bf16*)nullptr, A->out, DM, Tp, DM / 64, MP, MS, st2, g2, b2, colb + 16384, colb + 18432}); }
    GSYNC();
    { TAIL_PTRS(); const Ids I = ids(); gate_fix(Tp, A->in[27] + L * DM, PLEB, T2, st2, g2, b2, colb + 16384, colb + 18432, L == 0 ? XB_ : (bf16*)nullptr, A->out, I.gt, I.ngt); }
#undef TAIL_PTRS
}
__global__ void __launch_bounds__(NTHR, 2) mega_fwd(Args A_) {
    extern __shared__ __attribute__((aligned(16))) unsigned char lds_raw[];
    LAS unsigned char* lds = (LAS unsigned char*)lds_raw;
    volatile LAS unsigned* bst = (volatile LAS unsigned*)(lds + LDS_BYTES - 16);
    if (threadIdx.x < 2) bst[threadIdx.x] = 0u;
    __syncthreads();
    const XcdBarrier xbar = xcd_barrier_post((unsigned*)(A_.ws + WS_COL + 512 * 1024), bst);

#ifdef PROBE_PRO
    for (int rep = 0; rep < 2; ++rep)
#endif
    { KA A = kargs(); const Ids I = ids(); unsigned char* ws = A->ws; const size_t gt = I.gt, ngt = I.ngt; bf16* YR1 = (bf16*)A->out; bf16* Pb = (bf16*)(ws + WS_PB);
      LAS float* scr = (LAS float*)(lds + I.wid * 16384);
#ifndef NO_ROPE
        for (size_t i = gt; i < (size_t)NPOS * 96; i += ngt) { const int pos = (int)(i / 96), k = (int)(i % 96); const bool big = k < 64; const int f = big ? k : k - 64;
            const float inv = exp2f(-(float)f * (big ? (2.0f / 128.0f) : (2.0f / 64.0f)) * 13.287712379549449f);
            const float ang = (float)pos * inv; const double a = (double)ang;
            f32x2 cs = {(float)cos(a), (float)sin(a)};
            if (big) ((f32x2*)(ws + WS_ROPE128))[(size_t)pos * 64 + f] = cs; else ((f32x2*)(ws + WS_ROPE64))[(size_t)pos * 32 + f] = cs; }
#endif
        float* colb = (float*)(ws + WS_COL);
        const WJob jobs[6] = { {A->in[10], DM, ABW, (bf16*)(ws + W_IN), nullptr, nullptr, nullptr, nullptr}, {A->in[13], DM, DM, (bf16*)(ws + W_OUT), nullptr, nullptr, nullptr, nullptr},
                               {A->in[24], DM, DFF, (bf16*)(ws + W_UP), A->in[20], A->in[21], colb, colb + 8192},
                               {A->in[25], DFF, DM, (bf16*)(ws + W_DOWN), nullptr, nullptr, nullptr, nullptr}, {A->in[26], DM, DM, (bf16*)(ws + W_GATE), A->in[22], A->in[23], colb + 16384, colb + 18432},
                               {A->in[28], PLED, DM, (bf16*)(ws + W_PLE), nullptr, nullptr, nullptr, nullptr} };
        transpose_jobs<6>(jobs, scr, I.gw, I.ngw, I.lane);
        cvt_flat(A->in[0], YR1, (size_t)MP * DM / 8, gt, ngt); cvt_flat(A->in[1], YR1 + (size_t)MP * DM, (size_t)MS * DM / 8, gt, ngt);
#pragma unroll
        for (int L = 0; L < 2; ++L) { cvt_flat(A->in[8] + (size_t)L * MP * PLED, Pb + (size_t)L * M * PLED, (size_t)MP * PLED / 8, gt, ngt);
            cvt_flat(A->in[9] + (size_t)L * MS * PLED, Pb + (size_t)L * M * PLED + (size_t)MP * PLED, (size_t)MS * PLED / 8, gt, ngt); }
    }
    cg::this_grid().sync();

    { KA A = kargs(); unsigned char* ws = A->ws; run_gemm(lds, (const bf16*)A->out, (const bf16*)(ws + W_IN), M, ABW, DM, pg8::EpiBf16<0>{(bf16*)(ws + WS_H), ABW}); }
#ifdef PROBE_G1
    __syncthreads(); { KA A = kargs(); unsigned char* ws = A->ws; run_gemm(lds, (const bf16*)A->out, (const bf16*)(ws + W_IN), M, ABW, DM, pg8::EpiBf16<0>{(bf16*)(ws + WS_H), ABW}); }
#endif
    GSYNC();
#ifndef NO_POST
    { const Ids I = ids(); l0_post(kargs(), I.gw, I.ngw, I.lane, I.gt, I.ngt); }
#ifdef PROBE_POST
    __syncthreads(); { const Ids I = ids(); l0_post(kargs(), I.gw, I.ngw, I.lane, I.gt, I.ngt, false); }
#endif
#endif
    GSYNC();
#ifndef NO_ATT0
    { const Ids I = ids(); attn_l0(kargs(), lds, I.wid); }
#endif
#ifdef PROBE_ATT
    __syncthreads(); { const Ids I = ids(); attn_l0(kargs(), lds, I.wid); }
#endif
    GSYNC();
    layer_tail<0>(xbar, lds, WS_O0, true);
#ifdef PROBE_MISC
    for (int rep = 0; rep < 2; ++rep)
#endif
    { KA A = kargs(); const Ids I = ids(); unsigned char* ws = A->ws; LAS float* scr = (LAS float*)(lds + I.wid * 16384);
      float* colb = (float*)(ws + WS_COL) + 20480;
      const WJob jobs[8] = { {A->in[14], DM, CINW, (bf16*)(ws + W_IN), nullptr, nullptr, nullptr, nullptr}, {A->in[16], CQR, 3072, (bf16*)(ws + W_QB), nullptr, nullptr, nullptr, nullptr},
                             {A->in[18], CKVR, 4096, (bf16*)(ws + W_KVB), nullptr, nullptr, nullptr, nullptr}, {A->in[19], DM, DM, (bf16*)(ws + W_OUT), nullptr, nullptr, nullptr, nullptr},
                             {A->in[24] + (size_t)DM * DFF, DM, DFF, (bf16*)(ws + W_UP), A->in[20] + DM, A->in[21] + DM, colb, colb + 8192}, {A->in[25] + (size_t)DFF * DM, DFF, DM, (bf16*)(ws + W_DOWN), nullptr, nullptr, nullptr, nullptr},
                             {A->in[26] + (size_t)DM * DM, DM, DM, (bf16*)(ws + W_GATE), A->in[22] + DM, A->in[23] + DM, colb + 16384, colb + 18432}, {A->in[28] + (size_t)PLED * DM, PLED, DM, (bf16*)(ws + W_PLE), nullptr, nullptr, nullptr, nullptr} };
      transpose_jobs<8>(jobs, scr, I.gw, I.ngw, I.lane);
      v4u z = {0u, 0u, 0u, 0u}; v4u* zp = (v4u*)((bf16*)(ws + W_IN) + (size_t)CINW * DM);
      for (size_t i = I.gt; i < (size_t)(CINP - CINW) * DM / 8; i += I.ngt) zp[i] = z; }
    GSYNC();
    { KA A = kargs(); unsigned char* ws = A->ws; run_gemm(lds, (const bf16*)A->out + (size_t)M * DM, (const bf16*)(ws + W_IN), M, CINP, DM, pg8::EpiBf16<0>{(bf16*)(ws + WS_HC), CINP}); }
#ifdef PROBE_G1
    __syncthreads(); { KA A = kargs(); unsigned char* ws = A->ws; run_gemm(lds, (const bf16*)A->out + (size_t)M * DM, (const bf16*)(ws + W_IN), M, CINP, DM, pg8::EpiBf16<0>{(bf16*)(ws + WS_HC), CINP}); }
#endif
    GSYNC();
#ifndef NO_POST
    { const Ids I = ids(); l1_norm(kargs(), I.gw, I.ngw, I.lane, I.gt, I.ngt); }
#ifdef PROBE_MISC
    { const Ids I = ids(); l1_norm(kargs(), I.gw, I.ngw, I.lane, I.gt, I.ngt); }
#endif
#endif
    GSYNC();
    { KA A = kargs(); unsigned char* ws = A->ws;
      run_gemm(lds, (const bf16*)(ws + WS_CQN), (const bf16*)(ws + W_QB), M, 3072, CQR, pg8::EpiBf16<0>{(bf16*)(ws + WS_Q), 3072});
      run_gemm(lds, (const bf16*)(ws + WS_CKV), (const bf16*)(ws + W_KVB), MKV, 4096, CKVR, pg8::EpiBf16<0>{(bf16*)(ws + WS_KV), 4096});
#ifdef PROBE_G1
      __syncthreads(); run_gemm(lds, (const bf16*)(ws + WS_CQN), (const bf16*)(ws + W_QB), M, 3072, CQR, pg8::EpiBf16<0>{(bf16*)(ws + WS_Q), 3072});
      run_gemm(lds, (const bf16*)(ws + WS_CKV), (const bf16*)(ws + W_KVB), MKV, 4096, CKVR, pg8::EpiBf16<0>{(bf16*)(ws + WS_KV), 4096});
#endif
    }
    GSYNC();
#ifndef NO_ATT1
    { const Ids I = ids(); attn_l1(kargs(), lds, I.wid); }
#endif
#ifdef PROBE_ATT
    __syncthreads(); { const Ids I = ids(); attn_l1(kargs(), lds, I.wid); }
#endif
    GSYNC();
    layer_tail<1>(xbar, lds, WS_O1, false);
}

extern "C" void kernel_launch(void* const* d_in, const int* in_sizes, int n_in, void* d_out, int out_size, void* d_ws, size_t ws_size, hipStream_t stream) {
    static int grid = 0;
    if (grid == 0) {
        if (n_in != 29 || (size_t)out_size != O_END || ws_size < WS_NEED) { fprintf(stderr, "kernel_launch: unexpected shapes (n_in %d, out %d, ws %zu)\n", n_in, out_size, ws_size); grid = -1; return; }
        int dev = 0, cus = 0, per_cu = 0;
        hipGetDevice(&dev); hipDeviceGetAttribute(&cus, hipDeviceAttributeMultiprocessorCount, dev);
        if (hipFuncSetAttribute((const void*)mega_fwd, hipFuncAttributeMaxDynamicSharedMemorySize, LDS_BYTES) != hipSuccess) { fprintf(stderr, "kernel_launch: hipFuncSetAttribute failed\n"); grid = -1; return; }
        if (hipOccupancyMaxActiveBlocksPerMultiprocessor(&per_cu, (const void*)mega_fwd, NTHR, LDS_BYTES) != hipSuccess || per_cu < 1) { fprintf(stderr, "kernel_launch: occupancy query says %d\n", per_cu); per_cu = 1; }
        (void)hipGetLastError();
        grid = cus * 1;
    }
    if (grid < 0) return;
    if (hipMemsetAsync((char*)d_ws + WS_STATS, 0, WS_ZERO_BYTES, stream) != hipSuccess) { fprintf(stderr, "kernel_launch: hipMemsetAsync (stats) failed\n"); return; }
    Args a{};
    for (int i = 0; i < 29; ++i) a.in[i] = (const float*)d_in[i];
    a.out = (float*)d_out; a.ws = (unsigned char*)d_ws;
    void* args[] = {&a};
    hipError_t e = hipLaunchCooperativeKernel((const void*)mega_fwd, dim3(grid), dim3(NTHR), args, LDS_BYTES, stream);
    if (e != hipSuccess) fprintf(stderr, "cooperative launch failed: %s (grid %d)\n", hipGetErrorString(e), grid);
}
```
